# Optimizing an MI355X kernel written in HIP

```python
import math
import jax
import jax.numpy as jnp
from jax import lax
import numpy as np

D_MODEL = 1024
BATCH = 4
SEQ = 8192
DEPTH = 2

SSD_HEADS = 8
SSD_HEAD_DIM = 64
SSD_INNER = SSD_HEADS * SSD_HEAD_DIM
SSD_GROUPS = 2
SSD_STATE = 64
SSD_CONV = 5
SSD_CHUNK = 128
SSD_CONV_CH = SSD_INNER + 2 * SSD_GROUPS * SSD_STATE
S5_GROUP_CH = 16
S5_GROUPS = 24
S5_WIDTH = S5_GROUPS * S5_GROUP_CH
S5_STATE = 64
S5_MAX_RE = -1e-4
RET_HEADS = 8
RET_HEAD_DIM = 64
RET_WIDTH = RET_HEADS * RET_HEAD_DIM
RET_CHUNK = 128
ROPE_BASE = 10000.0
N_BRANCH = 3
D_FF = 2816
EPS = 1e-6
IN_PROJ_SIZES = (SSD_INNER, SSD_CONV_CH, 2 * SSD_HEADS, S5_WIDTH,
                 RET_WIDTH, RET_WIDTH, RET_WIDTH, RET_WIDTH, N_BRANCH * D_MODEL)
D_IN_PROJ = sum(IN_PROJ_SIZES)

kernel_name = 'hybrid_ssd_s5_retention_macaron_encoder'


def rmsnorm(x, g):
    xf = x.astype(jnp.float32)
    y = xf * lax.rsqrt(jnp.mean(xf * xf, axis=-1, keepdims=True) + EPS)
    return (y * g.astype(jnp.float32)).astype(x.dtype)


def swiglu(x, w_gate, w_up, w_down):
    return (jax.nn.silu(x @ w_gate) * (x @ w_up)) @ w_down


def dwconv_centered(x, w, b):
    k, c = w.shape
    pad = k // 2
    y = lax.conv_general_dilated(x, w[:, None, :], window_strides=(1,), padding=[(pad, pad)],
                                 dimension_numbers=('NWC', 'WIO', 'NWC'), feature_group_count=c)
    return y + b


def segsum_exp(a):
    t = a.shape[-1]
    xa = jnp.broadcast_to(a[..., :, None], a.shape + (t,))
    xa = jnp.where(jnp.tril(jnp.ones((t, t), bool), -1), xa, 0.0)
    ss = jnp.cumsum(xa, axis=-2)
    return jnp.exp(jnp.where(jnp.tril(jnp.ones((t, t), bool)), ss, -jnp.inf))


def ssd_causal(x, dt, a, bm, cm):
    b, s, h, p = x.shape
    n = bm.shape[-1]
    L = SSD_CHUNK
    c = s // L
    xd = (x * dt[..., None]).reshape(b, c, L, h, p)
    da = (dt * a).reshape(b, c, L, h).transpose(0, 3, 1, 2)
    bm = bm.reshape(b, c, L, h, n)
    cm = cm.reshape(b, c, L, h, n)
    da_cs = jnp.cumsum(da, axis=-1)
    scores = jnp.einsum('bclhn,bcshn->bhcls', cm, bm) * segsum_exp(da)
    y_diag = jnp.einsum('bhcls,bcshp->bclhp', scores, xd)
    decay_states = jnp.exp(da_cs[..., -1:] - da_cs).transpose(0, 2, 3, 1)
    states = jnp.einsum('bclhn,bclhp->bchpn', bm * decay_states[..., None], xd)
    chunk_decay = segsum_exp(jnp.pad(da_cs[..., -1], ((0, 0), (0, 0), (1, 0))))
    states = jnp.concatenate([jnp.zeros_like(states[:, :1]), states], axis=1)
    states = jnp.einsum('bhzc,bchpn->bzhpn', chunk_decay, states)[:, :-1]
    out_decay = jnp.exp(da_cs).transpose(0, 2, 3, 1)
    y_off = jnp.einsum('bclhn,bchpn->bclhp', cm, states) * out_decay[..., None]
    return (y_diag + y_off).reshape(b, s, h, p)


def ssd_branch(z, xbc, dt_raw, conv_w, conv_b, dt_bias, a_log, d_skip, norm_g):
    b, s, _ = z.shape
    f32 = jnp.float32
    xbc = jax.nn.silu(dwconv_centered(xbc, conv_w, conv_b))
    xs, bm, cm = jnp.split(xbc, [SSD_INNER, SSD_INNER + SSD_GROUPS * SSD_STATE], axis=-1)
    rep = SSD_HEADS // SSD_GROUPS
    xs = xs.astype(f32).reshape(b, s, SSD_HEADS, SSD_HEAD_DIM)
    bm = jnp.repeat(bm.astype(f32).reshape(b, s, SSD_GROUPS, SSD_STATE), rep, axis=2)
    cm = jnp.repeat(cm.astype(f32).reshape(b, s, SSD_GROUPS, SSD_STATE), rep, axis=2)
    dt = jax.nn.softplus(dt_raw.astype(f32).reshape(b, s, 2, SSD_HEADS) + dt_bias.astype(f32))
    a = -jnp.exp(a_log.astype(f32))
    flip = lambda t: jnp.flip(t, axis=1)
    y_fwd = ssd_causal(xs, dt[:, :, 0], a[0], bm, cm)
    y_bwd = flip(ssd_causal(flip(xs), flip(dt[:, :, 1]), a[1], flip(bm), flip(cm)))
    y = y_fwd + y_bwd + d_skip.astype(f32)[:, None] * xs
    y = y.reshape(b, s, SSD_INNER).astype(z.dtype)
    return rmsnorm(y * jax.nn.silu(z), norm_g)


def s5_direction(u, lam_re, lam_im, log_step, b_re, b_im, reverse):
    f32 = jnp.float32
    lam_re = jnp.minimum(lam_re.astype(f32), S5_MAX_RE)
    lam_im = lam_im.astype(f32)
    step = jnp.exp(log_step.astype(f32))[:, None]
    mag = jnp.exp(lam_re * step)
    ang = lam_im * step
    lb_re = mag * jnp.cos(ang)
    lb_im = mag * jnp.sin(ang)
    den = lam_re * lam_re + lam_im * lam_im
    nr = lb_re - 1.0
    coef_re = ((nr * lam_re + lb_im * lam_im) / den)[..., None]
    coef_im = ((lb_im * lam_re - nr * lam_im) / den)[..., None]
    b_re = b_re.astype(f32)
    b_im = b_im.astype(f32)
    bb_re = coef_re * b_re - coef_im * b_im
    bb_im = coef_re * b_im + coef_im * b_re
    bu_re = jnp.einsum('gph,bsgh->bsgp', bb_re, u)
    bu_im = jnp.einsum('gph,bsgh->bsgp', bb_im, u)
    s = u.shape[1]
    a_re = jnp.broadcast_to(lb_re, (1, s) + lb_re.shape)
    a_im = jnp.broadcast_to(lb_im, (1, s) + lb_im.shape)

    def combine(e1, e2):
        a1r, a1i, b1r, b1i = e1
        a2r, a2i, b2r, b2i = e2
        return (a2r * a1r - a2i * a1i,
                a2r * a1i + a2i * a1r,
                a2r * b1r - a2i * b1i + b2r,
                a2r * b1i + a2i * b1r + b2i)

    _, _, h_re, h_im = lax.associative_scan(combine, (a_re, a_im, bu_re, bu_im), reverse=reverse, axis=1)
    return h_re, h_im


def s5_branch(u, lam_re, lam_im, log_step, b_re, b_im, c_re, c_im, d_s5, glu_wv, glu_wg):
    b, s, _ = u.shape
    f32 = jnp.float32
    uf = u.astype(f32).reshape(b, s, S5_GROUPS, S5_GROUP_CH)
    y = d_s5.astype(f32) * uf
    for direction, rev in ((0, False), (1, True)):
        h_re, h_im = s5_direction(uf, lam_re[direction], lam_im[direction], log_step[direction],
                                  b_re, b_im, rev)
        y = y + jnp.einsum('ghp,bsgp->bsgh', c_re[direction].astype(f32), h_re) \
              - jnp.einsum('ghp,bsgp->bsgh', c_im[direction].astype(f32), h_im)
    y = jax.nn.gelu(y.reshape(b, s, S5_WIDTH)).astype(u.dtype)
    return (y @ glu_wv) * jax.nn.sigmoid(y @ glu_wg)


def rotary(t, cos, sin):
    t1, t2 = jnp.split(t, 2, axis=-1)
    return jnp.concatenate([t1 * cos - t2 * sin, t1 * sin + t2 * cos], axis=-1)


def retention_direction(q, k, v, log_gamma, inclusive):
    b, s, h, d = q.shape
    L = RET_CHUNK
    c = s // L
    q = q.reshape(b, c, L, h, d)
    k = k.reshape(b, c, L, h, d)
    v = v.reshape(b, c, L, h, -1)
    idx = jnp.arange(L, dtype=jnp.float32)
    rel = idx[:, None] - idx[None, :]
    mask = jnp.tril(jnp.ones((L, L), bool), 0 if inclusive else -1)
    intra_decay = jnp.where(mask, jnp.exp(log_gamma[:, None, None] * jnp.where(mask, rel, 0.0)), 0.0)
    scores = jnp.einsum('bclhd,bcshd->bhcls', q, k) * intra_decay[:, None]
    y_intra = jnp.einsum('bhcls,bcshe->bclhe', scores, v)
    k_decay = jnp.exp(log_gamma[None, :] * (L - 1.0 - idx)[:, None])
    r = jnp.einsum('bclhd,bclhe->bchde', k * k_decay[:, :, None], v)
    ci = jnp.arange(c, dtype=jnp.float32)
    crel = ci[:, None] - ci[None, :] - 1.0
    cmask = jnp.tril(jnp.ones((c, c), bool), -1)
    chunk_decay = jnp.where(cmask, jnp.exp(log_gamma[:, None, None] * L * jnp.where(cmask, crel, 0.0)), 0.0)
    st = jnp.einsum('hij,bjhde->bihde', chunk_decay, r)
    q_decay = jnp.exp(log_gamma[None, :] * (idx + 1.0)[:, None])
    y_inter = jnp.einsum('bclhd,bchde->bclhe', q * q_decay[:, :, None], st)
    return (y_intra + y_inter).reshape(b, s, h, -1)


def retention_branch(q, k, v, g, norm_g):
    b, s, _ = q.shape
    f32 = jnp.float32
    shape = (b, s, RET_HEADS, RET_HEAD_DIM)
    pos = jnp.arange(s, dtype=f32)
    inv_freq = ROPE_BASE ** (-jnp.arange(0, RET_HEAD_DIM, 2, dtype=f32) / RET_HEAD_DIM)
    ang = pos[:, None] * inv_freq[None, :]
    cos = jnp.cos(ang)[None, :, None, :]
    sin = jnp.sin(ang)[None, :, None, :]
    qf = rotary(q.astype(f32).reshape(shape), cos, sin)
    kf = rotary(k.astype(f32).reshape(shape), cos, sin) * (RET_HEAD_DIM ** -0.5)
    vf = v.astype(f32).reshape(shape)
    log_gamma = jnp.log1p(-jnp.exp2(-5.0 - jnp.arange(RET_HEADS, dtype=f32)))
    flip = lambda t: jnp.flip(t, axis=1)
    y = retention_direction(qf, kf, vf, log_gamma, True) \
        + flip(retention_direction(flip(qf), flip(kf), flip(vf), log_gamma, False))
    y = y * lax.rsqrt(jnp.mean(y * y, axis=-1, keepdims=True) + EPS)
    y = y.reshape(b, s, RET_WIDTH) * norm_g.astype(f32)
    return (jax.nn.silu(g.astype(f32)) * y).astype(g.dtype)


def setup_inputs(seed: int = 0) -> dict:
    key = jax.random.key(seed)
    ks = iter(jax.random.split(key, 48))
    f32 = jnp.float32
    L = DEPTH
    D = D_MODEL

    def nrm(shape, scale):
        return scale * jax.random.normal(next(ks), shape, f32)

    def gain(shape):
        return 1.0 + nrm(shape, 0.02)

    x = jax.random.normal(next(ks), (BATCH, SEQ, D), f32)
    ffn1_norm = gain((L, D))
    ffn1_w_gate = nrm((L, D, D_FF), D ** -0.5)
    ffn1_w_up = nrm((L, D, D_FF), D ** -0.5)
    ffn1_w_down = nrm((L, D_FF, D), D_FF ** -0.5)
    mix_norm = gain((L, D))
    w_in = nrm((L, D, D_IN_PROJ), D ** -0.5)
    b_gate = nrm((L, N_BRANCH * D), 0.02)
    ssd_conv_w = nrm((L, SSD_CONV, SSD_CONV_CH), SSD_CONV ** -0.5)
    ssd_conv_b = nrm((L, SSD_CONV_CH), 0.02)
    dt0 = jnp.exp(jax.random.uniform(next(ks), (L, 2, SSD_HEADS), f32, math.log(1e-3), math.log(1e-1)))
    ssd_dt_bias = dt0 + jnp.log(-jnp.expm1(-dt0))
    ssd_a_log = jnp.log(jax.random.uniform(next(ks), (L, 2, SSD_HEADS), f32, 1.0, 16.0))
    ssd_d = 1.0 + nrm((L, SSD_HEADS), 0.1)
    ssd_norm = gain((L, SSD_INNER))
    w_br_ssd = nrm((L, SSD_INNER, D), SSD_INNER ** -0.5)
    s5_lam_re = -0.5 + nrm((L, 2, S5_GROUPS, S5_STATE), 0.01)
    s5_lam_im = jnp.pi * jnp.arange(S5_STATE, dtype=f32) + nrm((L, 2, S5_GROUPS, S5_STATE), 0.01)
    s5_log_step = jax.random.uniform(next(ks), (L, 2, S5_GROUPS), f32, math.log(1e-3), math.log(1e-1))
    s5_b_re = nrm((L, S5_GROUPS, S5_STATE, S5_GROUP_CH), (2 * S5_GROUP_CH) ** -0.5)
    s5_b_im = nrm((L, S5_GROUPS, S5_STATE, S5_GROUP_CH), (2 * S5_GROUP_CH) ** -0.5)
    s5_c_re = nrm((L, 2, S5_GROUPS, S5_GROUP_CH, S5_STATE), (2 * S5_STATE) ** -0.5)
    s5_c_im = nrm((L, 2, S5_GROUPS, S5_GROUP_CH, S5_STATE), (2 * S5_STATE) ** -0.5)
    s5_d = nrm((L, S5_GROUPS, S5_GROUP_CH), 1.0)
    s5_glu_wv = nrm((L, S5_WIDTH, S5_WIDTH), S5_WIDTH ** -0.5)
    s5_glu_wg = nrm((L, S5_WIDTH, S5_WIDTH), S5_WIDTH ** -0.5)
    w_br_s5 = nrm((L, S5_WIDTH, D), S5_WIDTH ** -0.5)
    ret_norm = gain((L, RET_WIDTH))
    w_br_ret = nrm((L, RET_WIDTH, D), RET_WIDTH ** -0.5)
    w_out = nrm((L, D, D), D ** -0.5)
    ffn2_norm = gain((L, D))
    ffn2_w_gate = nrm((L, D, D_FF), D ** -0.5)
    ffn2_w_up = nrm((L, D, D_FF), D ** -0.5)
    ffn2_w_down = nrm((L, D_FF, D), D_FF ** -0.5)
    final_norm = gain((D,))
    return {'x': x,
            'ffn1_norm': ffn1_norm, 'ffn1_w_gate': ffn1_w_gate, 'ffn1_w_up': ffn1_w_up, 'ffn1_w_down': ffn1_w_down,
            'mix_norm': mix_norm, 'w_in': w_in, 'b_gate': b_gate,
            'ssd_conv_w': ssd_conv_w, 'ssd_conv_b': ssd_conv_b, 'ssd_dt_bias': ssd_dt_bias,
            'ssd_a_log': ssd_a_log, 'ssd_d': ssd_d, 'ssd_norm': ssd_norm, 'w_br_ssd': w_br_ssd,
            's5_lam_re': s5_lam_re, 's5_lam_im': s5_lam_im, 's5_log_step': s5_log_step,
            's5_b_re': s5_b_re, 's5_b_im': s5_b_im, 's5_c_re': s5_c_re, 's5_c_im': s5_c_im,
            's5_d': s5_d, 's5_glu_wv': s5_glu_wv, 's5_glu_wg': s5_glu_wg, 'w_br_s5': w_br_s5,
            'ret_norm': ret_norm, 'w_br_ret': w_br_ret,
            'w_out': w_out,
            'ffn2_norm': ffn2_norm, 'ffn2_w_gate': ffn2_w_gate, 'ffn2_w_up': ffn2_w_up, 'ffn2_w_down': ffn2_w_down,
            'final_norm': final_norm}


def reference(x,
              ffn1_norm, ffn1_w_gate, ffn1_w_up, ffn1_w_down,
              mix_norm, w_in, b_gate,
              ssd_conv_w, ssd_conv_b, ssd_dt_bias, ssd_a_log, ssd_d, ssd_norm, w_br_ssd,
              s5_lam_re, s5_lam_im, s5_log_step, s5_b_re, s5_b_im, s5_c_re, s5_c_im,
              s5_d, s5_glu_wv, s5_glu_wg, w_br_s5,
              ret_norm, w_br_ret,
              w_out,
              ffn2_norm, ffn2_w_gate, ffn2_w_up, ffn2_w_down,
              final_norm):
    b, s, d = x.shape
    split_pts = np.cumsum(IN_PROJ_SIZES)[:-1].tolist()
    for i in range(DEPTH):
        x = x + 0.5 * swiglu(rmsnorm(x, ffn1_norm[i]), ffn1_w_gate[i], ffn1_w_up[i], ffn1_w_down[i])
        h = rmsnorm(x, mix_norm[i])
        proj = h @ w_in[i]
        z, xbc, dt_raw, u, q, k, v, g, gate_logits = jnp.split(proj, split_pts, axis=-1)
        y_ssd = ssd_branch(z, xbc, dt_raw, ssd_conv_w[i], ssd_conv_b[i], ssd_dt_bias[i],
                           ssd_a_log[i], ssd_d[i], ssd_norm[i]) @ w_br_ssd[i]
        y_s5 = s5_branch(u, s5_lam_re[i], s5_lam_im[i], s5_log_step[i], s5_b_re[i], s5_b_im[i],
                         s5_c_re[i], s5_c_im[i], s5_d[i], s5_glu_wv[i], s5_glu_wg[i]) @ w_br_s5[i]
        y_ret = retention_branch(q, k, v, g, ret_norm[i]) @ w_br_ret[i]
        gates = jax.nn.sigmoid(gate_logits + b_gate[i]).reshape(b, s, N_BRANCH, d)
        mixed = gates[:, :, 0] * y_ssd + gates[:, :, 1] * y_s5 + gates[:, :, 2] * y_ret
        x = x + mixed @ w_out[i]
        x = x + 0.5 * swiglu(rmsnorm(x, ffn2_norm[i]), ffn2_w_gate[i], ffn2_w_up[i], ffn2_w_down[i])
    return rmsnorm(x, final_norm)
```

```cpp
#include <hip/hip_runtime.h>
#include <hip/hip_cooperative_groups.h>
#include <cstdio>
#include <cstdint>
namespace cg = cooperative_groups;

#define LAS __attribute__((address_space(3)))
typedef unsigned short bf16_t;
typedef short bf16x8 __attribute__((ext_vector_type(8)));
typedef float f32x4 __attribute__((ext_vector_type(4)));
typedef float f32x8 __attribute__((ext_vector_type(8)));
typedef unsigned u32x4 __attribute__((ext_vector_type(4)));
typedef unsigned u32x2 __attribute__((ext_vector_type(2)));
typedef unsigned long long u64_t;
#define RS_SCALE 16777216.0f
#define RS_INV (1.0f / 16777216.0f)

constexpr int T_ALL = 32768, DM = 1024, TH = 16384, SEQ = 8192, FF = 2816, NP = 6912;
constexpr float EPS = 1e-6f;
constexpr int PC_Z = 0, PC_XBC = 512, PC_YBP = 1280, PC_Q = 1792, PC_K = 2304, PC_V = 2816, PC_G = 3328, PC_GATE = 3840;

constexpr size_t MiB = 1u << 20;
constexpr size_t WS_RS = 505 * MiB;
constexpr size_t WS_DEC = 3 * MiB / 2;
constexpr size_t WS_ROPE = 2 * MiB;
constexpr size_t WS_WGU1 = 4 * MiB, WS_WD1 = 15 * MiB, WS_WIN = 20 * MiB + MiB / 2, WS_WA = 34 * MiB, WS_WB = 35 * MiB,
                 WS_WGLU = 35 * MiB + 3 * MiB / 4, WS_WC = 36 * MiB + MiB / 2, WS_WOUT = 37 * MiB + MiB / 2, WS_WGU2 = 39 * MiB + MiB / 2,
                 WS_WD2 = 50 * MiB + MiB / 2, WS_S5S = 56 * MiB, WS_S5Y = 59 * MiB, WS_KTAB = 65 * MiB;
constexpr size_t WS_XB = 68 * MiB;
constexpr size_t WS_H = 132 * MiB;
constexpr size_t WS_P = 132 * MiB;
constexpr size_t WS_YA = 348 * MiB, WS_YB = 364 * MiB, WS_YC = 376 * MiB, WS_MIX = 392 * MiB, WS_ST = 424 * MiB,
                 WS_UG = 456 * MiB, WS_SC = 480 * MiB, WS_DT = 504 * MiB, WS_END = 508 * MiB;
constexpr int LDS_BYTES = 147456;

typedef __bf16 bf16v2_t __attribute__((ext_vector_type(2)));
typedef float f32v2_t __attribute__((ext_vector_type(2)));
__device__ __forceinline__ unsigned cvt_pk_bf16(float lo, float hi) { f32v2_t v = {lo, hi}; bf16v2_t b = __builtin_convertvector(v, bf16v2_t); return __builtin_bit_cast(unsigned, b); }
__device__ __forceinline__ unsigned f2bf(float f) { unsigned u = __builtin_bit_cast(unsigned, f); return (u + 0x7fffu + ((u >> 16) & 1u)) >> 16; }
__device__ __forceinline__ float bflo(unsigned u) { return __builtin_bit_cast(float, u << 16); }
__device__ __forceinline__ float bfhi(unsigned u) { return __builtin_bit_cast(float, u & 0xffff0000u); }
__device__ __forceinline__ float rcpf_(float x) { return __builtin_amdgcn_rcpf(x); }
__device__ __forceinline__ float sigmoidf_(float x) { return rcpf_(1.0f + __expf(-x)); }
__device__ __forceinline__ float shflx(float v, int mask, int lane) { return __builtin_bit_cast(float, __builtin_amdgcn_ds_bpermute((lane ^ mask) << 2, __builtin_bit_cast(int, v))); }
__device__ __forceinline__ void sincos_rev(float rev, float& s, float& c) { const float f = rev - floorf(rev); s = __builtin_amdgcn_sinf(f); c = __builtin_amdgcn_cosf(f); }
__device__ __forceinline__ float siluf_(float x) { return x * sigmoidf_(x); }
__device__ __forceinline__ float softplusf_(float x) { return fmaxf(x, 0.f) + __logf(1.0f + __expf(-fabsf(x))); }
__device__ __forceinline__ float gelu_tanh(float x) { const float u = 0.7978845608028654f * (x + 0.044715f * x * x * x); const float t = 1.0f - 2.0f * rcpf_(__expf(2.0f * u) + 1.0f); return 0.5f * x * (1.0f + t); }
__device__ __forceinline__ f32x8 unpack8(u32x4 v) { f32x8 o; o[0] = bflo(v.x); o[1] = bfhi(v.x); o[2] = bflo(v.y); o[3] = bfhi(v.y); o[4] = bflo(v.z); o[5] = bfhi(v.z); o[6] = bflo(v.w); o[7] = bfhi(v.w); return o; }
__device__ __forceinline__ u32x4 pack8(f32x4 a, f32x4 b) { u32x4 w; w.x = cvt_pk_bf16(a[0], a[1]); w.y = cvt_pk_bf16(a[2], a[3]); w.z = cvt_pk_bf16(b[0], b[1]); w.w = cvt_pk_bf16(b[2], b[3]); return w; }
__device__ __forceinline__ float wave_sum(float v, int lane) {
#pragma unroll
    for (int o = 1; o < 64; o <<= 1) v += shflx(v, o, lane);
    return v;
}

namespace pg8 {
constexpr int BM = 256, BK = 64, HALF = 128, HTB = HALF * BK * 2, NXCD = 8, WGM = 8;
__device__ __forceinline__ int lds_byte(int r, int c) { const int st = (r >> 4) * 2 + (c >> 5), rr = r & 15, cc = c & 31, ob = rr * 64 + cc * 2; return st * 1024 + (ob ^ (((ob >> 9) & 1) << 5)); }
__device__ __forceinline__ void stage_rc(int b, int& R, int& C) { const int st = b / 1024, sb = b % 1024, swz = sb ^ (((sb >> 9) & 1) << 5); R = (st >> 1) * 16 + swz / 64; C = (st & 1) * 32 + (swz % 64) / 2; }
__device__ __forceinline__ int perm32(int rho) { const int n = rho >> 4, i = rho & 15; return 8 * (i >> 2) + 4 * n + (i & 3); }

struct Unit { int pm, pn; };
struct Gemm { const bf16_t* A; const bf16_t* Bt; int lda, ldb, K; };

struct SchedFull {
    int nM, nN, nwg, G, c;
    __device__ void init(int nM_, int nN_, int G_, int c_) { nM = nM_; nN = nN_; nwg = nM * nN; G = G_; c = c_; }
    __device__ bool next(int i, Unit& u) const {
        const long L = (long)i * G + c; if (L >= nwg) return false;
        int wgid = (int)L; { const int q = nwg / NXCD, r = nwg % NXCD, xcd = wgid % NXCD, off = wgid / NXCD; wgid = (xcd < r ? xcd * (q + 1) : r * (q + 1) + (xcd - r) * q) + off; }
        const int nig = WGM * nN, gid = wgid / nig, fm = gid * WGM, gsz = (nM - fm) < WGM ? (nM - fm) : WGM;
        u.pm = fm + ((wgid % nig) % gsz); u.pn = (wgid % nig) / gsz; return true;
    }
};
struct SchedGrp {
    int mt, nt, ng, G, c;
    __device__ void init(int mt_, int nt_, int ng_, int G_, int c_) { mt = mt_; nt = nt_; ng = ng_; G = G_; c = c_; }
    __device__ bool next(int i, Unit& u) const {
        const int L = i * G + c; if (L >= ng * mt * nt) return false;
        const int g = L / (mt * nt), r = L % (mt * nt); u.pm = g * mt + r / nt; u.pn = g * nt + r % nt; return true;
    }
};

template <class Epi, class Sched>
__device__ __forceinline__ void gemm_phase(LAS unsigned char* lds, const Gemm g, const Sched& S, const Epi& E, int tid) {
    const int wid = __builtin_amdgcn_readfirstlane(tid >> 6), lane = tid & 63, wr = wid >> 2, wc = wid & 3, fr = lane & 15, fq = lane >> 4;
    const int K = g.K, nt = K / BK;
    unsigned voffA[2], voffB[2];
#pragma unroll
    for (int i = 0; i < 2; ++i) { int R, C; stage_rc(tid * 16 + i * 8192, R, C); const int Rb = (R & ~31) + perm32(R & 31);
        voffA[i] = (unsigned)(R * g.lda + C) * 2u; voffB[i] = (unsigned)(Rb * g.ldb + C) * 2u; }
    const size_t kstep = (size_t)(BK * 2);
    const size_t hstepA = (size_t)HALF * g.lda * 2, hstepB = (size_t)HALF * g.ldb * 2;
    const size_t tstepA = 2 * hstepA, tstepB = 2 * hstepB;
    const unsigned ldsw = (unsigned)wid * 1024u;
    const int aoff = lds_byte(wr * 64 + fr, fq * 8), boff = lds_byte(wc * 32 + fr, fq * 8);
#define PG8_SA(b, h) (((b) * 2 + (h)) * HTB)
#define PG8_SB(b, h) ((4 + (b) * 2 + (h)) * HTB)
#define PG8_STAGE(bufoff, gbase, voff) do { _Pragma("unroll") for (int _i = 0; _i < 2; ++_i) \
        __builtin_amdgcn_global_load_lds((const unsigned*)((const char*)(gbase) + (voff)[_i]), (LAS unsigned*)(lds + (bufoff) + ldsw + _i * 8192), 16, 0, 0); } while (0)
#define PG8_LDA(dst, b, h) do { _Pragma("unroll") for (int m = 0; m < 4; ++m) _Pragma("unroll") for (int k = 0; k < 2; ++k) dst[m][k] = *(const LAS bf16x8*)(lds + PG8_SA(b, h) + aoff + m * 2048 + k * 1024); } while (0)
#define PG8_LDB(dst, b, h) do { _Pragma("unroll") for (int n = 0; n < 2; ++n) _Pragma("unroll") for (int k = 0; k < 2; ++k) dst[n][k] = *(const LAS bf16x8*)(lds + PG8_SB(b, h) + boff + n * 2048 + k * 1024); } while (0)
#define PG8_MMA(ai, bj, At, Bt) do { __builtin_amdgcn_s_setprio(1); _Pragma("unroll") for (int m = 0; m < 4; ++m) _Pragma("unroll") for (int n = 0; n < 2; ++n) _Pragma("unroll") for (int k = 0; k < 2; ++k) \
        acc[ai][bj][m][n] = __builtin_amdgcn_mfma_f32_16x16x32_bf16(Bt[n][k], At[m][k], acc[ai][bj][m][n], 0, 0, 0); __builtin_amdgcn_s_setprio(0); } while (0)
#define PG8_WAIT_V(n) asm volatile("s_waitcnt vmcnt(" #n ")" ::: "memory")
#define PG8_WAIT_L(n) asm volatile("s_waitcnt lgkmcnt(" #n ")" ::: "memory")
#define PG8_BAR __builtin_amdgcn_s_barrier()
#define PG8_SCHED __builtin_amdgcn_sched_barrier(0)
    Unit cur, nxt; int ui = 0;
    if (!S.next(0, cur)) return;
    f32x4 acc[2][2][4][2];
#pragma unroll
    for (int a = 0; a < 2; ++a)
#pragma unroll
        for (int b = 0; b < 2; ++b)
#pragma unroll
            for (int m = 0; m < 4; ++m)
#pragma unroll
                for (int n = 0; n < 2; ++n) acc[a][b][m][n] = (f32x4){0.f, 0.f, 0.f, 0.f};
    bf16x8 At[4][2], B0[2][2], B1[2][2];
    const char* cA = (const char*)g.A + (size_t)cur.pm * tstepA; const char* cB = (const char*)g.Bt + (size_t)cur.pn * tstepB;
    PG8_STAGE(PG8_SB(0, 0), cB, voffB); PG8_STAGE(PG8_SB(0, 1), cB + hstepB, voffB); PG8_STAGE(PG8_SA(0, 0), cA, voffA); PG8_STAGE(PG8_SA(0, 1), cA + hstepA, voffA);
    if (wr == 1) PG8_BAR;
    PG8_WAIT_V(2); PG8_BAR;
    PG8_STAGE(PG8_SB(1, 0), cB + kstep, voffB); PG8_STAGE(PG8_SA(1, 0), cA + kstep, voffA); PG8_STAGE(PG8_SB(1, 1), cB + hstepB + kstep, voffB);
    PG8_WAIT_V(6); PG8_BAR;
    for (;;) {
        const bool has_next = S.next(ui + 1, nxt);
        const char* nA = has_next ? (const char*)g.A + (size_t)nxt.pm * tstepA : cA; const char* nB = has_next ? (const char*)g.Bt + (size_t)nxt.pn * tstepB : cB;
        for (int t = 0; t < nt; t += 2) {
            const bool last = (t == nt - 2);
            const char* a1 = cA + (size_t)(t + 1) * kstep;
            const char* a2 = last ? nA : cA + (size_t)(t + 2) * kstep; const char* b2 = last ? nB : cB + (size_t)(t + 2) * kstep;
            const char* a3 = a2 + kstep; const char* b3 = b2 + kstep;
            PG8_LDB(B0, 0, 0); PG8_LDB(B1, 0, 1); PG8_SCHED; PG8_LDA(At, 0, 0); PG8_STAGE(PG8_SA(1, 1), a1 + hstepA, voffA);
            PG8_WAIT_V(8); PG8_WAIT_L(0); PG8_BAR; PG8_MMA(0, 0, At, B0); PG8_MMA(0, 1, At, B1); PG8_BAR; PG8_SCHED;
            PG8_LDA(At, 0, 1); PG8_STAGE(PG8_SB(0, 0), b2, voffB); PG8_STAGE(PG8_SB(0, 1), b2 + hstepB, voffB); PG8_STAGE(PG8_SA(0, 0), a2, voffA);
            PG8_WAIT_V(8); PG8_WAIT_L(0); PG8_BAR; PG8_MMA(1, 0, At, B0); PG8_MMA(1, 1, At, B1); PG8_BAR; PG8_SCHED;
            PG8_LDB(B0, 1, 0); PG8_LDB(B1, 1, 1); PG8_SCHED; PG8_LDA(At, 1, 0); PG8_STAGE(PG8_SA(0, 1), a2 + hstepA, voffA);
            PG8_WAIT_V(8); PG8_WAIT_L(0); PG8_BAR; PG8_MMA(0, 0, At, B0); PG8_MMA(0, 1, At, B1); PG8_BAR; PG8_SCHED;
            PG8_LDA(At, 1, 1); PG8_STAGE(PG8_SB(1, 0), b3, voffB); PG8_STAGE(PG8_SB(1, 1), b3 + hstepB, voffB); PG8_STAGE(PG8_SA(1, 0), a3, voffA);
            PG8_WAIT_V(8); PG8_WAIT_L(0); PG8_BAR; PG8_MMA(1, 0, At, B0); PG8_MMA(1, 1, At, B1); PG8_BAR; PG8_SCHED;
        }
        if (wr == 0) PG8_BAR;
        { int z_ = 0; asm volatile("" : "+s"(z_)); const int l2 = __builtin_amdgcn_mbcnt_hi(~0u, __builtin_amdgcn_mbcnt_lo(~0u, z_));
          E(acc, cur, wr, wc, l2 & 15, l2 >> 4); }
        if (!has_next) break;
#pragma unroll
        for (int a = 0; a < 2; ++a)
#pragma unroll
            for (int b = 0; b < 2; ++b)
#pragma unroll
                for (int m = 0; m < 4; ++m)
#pragma unroll
                    for (int n = 0; n < 2; ++n) acc[a][b][m][n] = (f32x4){0.f, 0.f, 0.f, 0.f};
        cur = nxt; cA = nA; cB = nB; ++ui;
        if (wr == 1) PG8_BAR;
    }
    PG8_WAIT_V(0);
    PG8_BAR;
#undef PG8_SA
#undef PG8_SB
#undef PG8_STAGE
#undef PG8_LDA
#undef PG8_LDB
#undef PG8_MMA
#undef PG8_WAIT_V
#undef PG8_WAIT_L
#undef PG8_BAR
#undef PG8_SCHED
}
}
using pg8::Unit;
typedef f32x4 Acc[2][2][4][2];

struct Args { const float* in[34]; float* out; unsigned char* ws; };
typedef const __attribute__((address_space(4))) Args* KArgP;
#define KARGS() KArgP ap = (KArgP)__builtin_amdgcn_kernarg_segment_ptr(); asm volatile("" : "+s"(ap)); unsigned char* ws = ap->ws; (void)ws
#define TID_LOCAL() int z_ = 0; asm volatile("" : "+s"(z_)); const int lane = __builtin_amdgcn_mbcnt_hi(~0u, __builtin_amdgcn_mbcnt_lo(~0u, z_)); int wave = wave0; asm volatile("" : "+s"(wave)); const int tid = wave * 64 + lane; const int gw = bid * 8 + wave, gt = bid * 512 + tid; (void)lane; (void)wave; (void)gw; (void)gt
#define WSP(type, off) ((type*)(ws + (off)))
#define PHASE() KARGS(); int bid = blockIdx.x, G = gridDim.x; asm volatile("" : "+s"(bid), "+s"(G)); LAS unsigned char* lds = lds0; asm volatile("" : "+s"(lds)); const int NGW = G * 8, NGT = G * 512; (void)NGW; (void)NGT
struct EpiGU {
    int rs_in;
    __device__ __forceinline__ void operator()(const Acc& acc, const Unit& u, int wr, int wc, int fr, int fq) const {
        KARGS(); bf16_t* H = WSP(bf16_t, WS_H); const u64_t* rs = WSP(u64_t, WS_RS) + (size_t)rs_in * T_ALL;
        const int rowb = u.pm * 256 + wr * 64 + fr; const int hc = u.pn * 128 + wc * 32 + fq * 8;
#pragma unroll
        for (int ai = 0; ai < 2; ++ai)
#pragma unroll
            for (int m = 0; m < 4; ++m) { const int row = rowb + ai * 128 + m * 16; const float rstd = rsqrtf((float)rs[row] * (RS_INV / DM) + EPS);
                f32x4 h0, h1;
#pragma unroll
                for (int i = 0; i < 4; ++i) { h0[i] = siluf_(acc[ai][0][m][0][i] * rstd) * (acc[ai][1][m][0][i] * rstd); h1[i] = siluf_(acc[ai][0][m][1][i] * rstd) * (acc[ai][1][m][1][i] * rstd); }
                *(u32x4*)(H + (size_t)row * FF + hc) = pack8(h0, h1); }
    }
};
struct EpiRes {
    int base_in; int row0; int rs_o; float coef;
    __device__ __forceinline__ void operator()(const Acc& acc, const Unit& u, int wr, int wc, int fr, int fq) const {
        KARGS(); (void)base_in;
        bf16_t* XB = WSP(bf16_t, WS_XB) + (size_t)row0 * DM; u64_t* rs_out = WSP(u64_t, WS_RS) + (size_t)rs_o * T_ALL + row0;
        const int rowb = u.pm * 256 + wr * 64 + fr; const int cl = u.pn * 256 + wc * 32 + 8 * fq;
#pragma unroll
        for (int ai = 0; ai < 2; ++ai)
#pragma unroll
            for (int m = 0; m < 4; ++m) { const int row = rowb + ai * 128 + m * 16; float ss = 0.f;
#pragma unroll
                for (int bj = 0; bj < 2; ++bj) { const size_t off = (size_t)row * DM + cl + bj * 128;
                    const f32x8 bv = unpack8(*(const u32x4*)(XB + off));
                    f32x4 x0, x1;
#pragma unroll
                    for (int i = 0; i < 4; ++i) { x0[i] = bv[i] + coef * acc[ai][bj][m][0][i]; x1[i] = bv[4 + i] + coef * acc[ai][bj][m][1][i]; }
                    *(u32x4*)(XB + off) = pack8(x0, x1);
                    ss += (x0[0] * x0[0] + x0[1] * x0[1]) + (x0[2] * x0[2] + x0[3] * x0[3]) + (x1[0] * x1[0] + x1[1] * x1[1]) + (x1[2] * x1[2] + x1[3] * x1[3]); }
                { const int ln = fq * 16 + fr; ss += shflx(ss, 16, ln); ss += shflx(ss, 32, ln); }
                if (fq == 0) atomicAdd(rs_out + row, (u64_t)(ss * RS_SCALE)); }
    }
};
struct EpiInproj {
    int row0; int rs_b; int layer;
    __device__ __forceinline__ void operator()(const Acc& acc, const Unit& u, int wr, int wc, int fr, int fq) const {
        KARGS(); bf16_t* P = WSP(bf16_t, WS_P); bf16_t* UG = WSP(bf16_t, WS_UG); float* DT = WSP(float, WS_DT); const u64_t* rs = WSP(u64_t, WS_RS) + (size_t)rs_b * T_ALL + row0;
        const float* ropec = WSP(float, WS_ROPE); const float* ropes = ropec + SEQ * 32; const float* bgate = ap->in[7] + layer * 3072;
        const int pn = u.pn; const int rowb = u.pm * 256 + wr * 64 + fr; const int cl = wc * 32 + 8 * fq;
#pragma unroll
        for (int ai = 0; ai < 2; ++ai)
#pragma unroll
            for (int m = 0; m < 4; ++m) { const int row = rowb + ai * 128 + m * 16; const float rstd = rsqrtf((float)rs[row] * (RS_INV / DM) + EPS);
#pragma unroll
                for (int bj = 0; bj < 2; ++bj) {
                    f32x4 v0 = acc[ai][bj][m][0] * rstd, v1 = acc[ai][bj][m][1] * rstd; const int col = pn * 256 + bj * 128 + cl;
                    if (pn <= 4 || (pn >= 11 && pn <= 14)) { *(u32x4*)(P + (size_t)row * NP + col) = pack8(v0, v1); }
                    else if (pn <= 6) { const int j0 = (pn - 5) * 256 + bj * 128 + cl;
                        if (j0 < 384) { const int g = j0 >> 4, c = j0 & 15; *(u32x4*)(UG + ((size_t)(g * 1024 + (row >> 4)) * 512) + (row & 15) * 16 + c) = pack8(v0, v1); }
                        else if (j0 < 400) { *(f32x4*)(DT + (size_t)row * 16 + (j0 - 384)) = v0; *(f32x4*)(DT + (size_t)row * 16 + (j0 - 384) + 4) = v1; } }
                    else if (pn <= 10) { const int gi = ((bj * 128 + cl) & 63) >> 3; const int pos = row & (SEQ - 1);
                        const f32x4 c = *(const f32x4*)(ropec + pos * 32 + gi * 4), s = *(const f32x4*)(ropes + pos * 32 + gi * 4);
                        f32x4 o0 = v0 * c - v1 * s, o1 = v0 * s + v1 * c; if (pn >= 9) { o0 = o0 * 0.125f; o1 = o1 * 0.125f; }
                        *(u32x4*)(P + (size_t)row * NP + col) = pack8(o0, o1); }
                    else { const int gidx = (pn - 15) * 256 + bj * 128 + cl; f32x4 b0, b1;
#pragma unroll
                        for (int i_ = 0; i_ < 4; ++i_) { b0[i_] = bgate[gidx + i_]; b1[i_] = bgate[gidx + 4 + i_]; }
#pragma unroll
                        for (int i = 0; i < 4; ++i) { v0[i] = sigmoidf_(v0[i] + b0[i]); v1[i] = sigmoidf_(v1[i] + b1[i]); }
                        *(u32x4*)(P + (size_t)row * NP + col) = pack8(v0, v1); } } }
    }
};
struct EpiS5S {
    int dummy;
    __device__ __forceinline__ void operator()(const Acc& acc, const Unit& u, int wr, int wc, int fr, int fq) const {
        KARGS(); float* SC = WSP(float, WS_SC);
        const int rowb = u.pm * 256 + wr * 64 + fr; const int cl = wc * 32 + 8 * fq;
#pragma unroll
        for (int ai = 0; ai < 2; ++ai)
#pragma unroll
            for (int m = 0; m < 4; ++m) { const int row = rowb + ai * 128 + m * 16;
#pragma unroll
                for (int bj = 0; bj < 2; ++bj) { float* o = SC + (size_t)row * 256 + bj * 128 + cl; *(f32x4*)o = acc[ai][bj][m][0]; *(f32x4*)(o + 4) = acc[ai][bj][m][1]; } }
    }
};
struct EpiS5Y {
    int dummy;
    __device__ __forceinline__ void operator()(const Acc& acc, const Unit& u, int wr, int wc, int fr, int fq) const {
        KARGS(); bf16_t* P = WSP(bf16_t, WS_P);
        const int rowb = u.pm * 256 + wr * 64 + fr; const int cl = wc * 32 + 8 * fq;
#pragma unroll
        for (int ai = 0; ai < 2; ++ai)
#pragma unroll
            for (int m = 0; m < 4; ++m) { const int R = rowb + ai * 128 + m * 16; const int g = R >> 10, chunk = R & 1023;
#pragma unroll
                for (int bj = 0; bj < 2; ++bj) { const int c0 = bj * 128 + cl; const int t = c0 >> 4, c = c0 & 15; f32x4 v0 = acc[ai][bj][m][0], v1 = acc[ai][bj][m][1];
#pragma unroll
                    for (int i = 0; i < 4; ++i) { v0[i] = gelu_tanh(v0[i]); v1[i] = gelu_tanh(v1[i]); }
                    *(u32x4*)(P + (size_t)(chunk * 16 + t) * NP + PC_YBP + g * 16 + c) = pack8(v0, v1); } }
    }
};
struct EpiGLU {
    int dummy;
    __device__ __forceinline__ void operator()(const Acc& acc, const Unit& u, int wr, int wc, int fr, int fq) const {
        KARGS(); bf16_t* YB = WSP(bf16_t, WS_YB);
        const int rowb = u.pm * 256 + wr * 64 + fr; const int hc = u.pn * 128 + wc * 32 + fq * 8;
#pragma unroll
        for (int ai = 0; ai < 2; ++ai)
#pragma unroll
            for (int m = 0; m < 4; ++m) { const int row = rowb + ai * 128 + m * 16; f32x4 h0, h1;
#pragma unroll
                for (int i = 0; i < 4; ++i) { h0[i] = acc[ai][0][m][0][i] * sigmoidf_(acc[ai][1][m][0][i]); h1[i] = acc[ai][0][m][1][i] * sigmoidf_(acc[ai][1][m][1][i]); }
                *(u32x4*)(YB + (size_t)row * 384 + hc) = pack8(h0, h1); }
    }
};
struct EpiBr {
    int gcol; int rss_row; int first;
    __device__ __forceinline__ void operator()(const Acc& acc, const Unit& u, int wr, int wc, int fr, int fq) const {
        KARGS(); bf16_t* MIX = WSP(bf16_t, WS_MIX); const bf16_t* P = WSP(bf16_t, WS_P); const u64_t* rss = (rss_row >= 0) ? (WSP(u64_t, WS_RS) + rss_row) : nullptr;
        const int rowb = u.pm * 256 + wr * 64 + fr; const int cl = u.pn * 256 + wc * 32 + 8 * fq;
#pragma unroll
        for (int ai = 0; ai < 2; ++ai)
#pragma unroll
            for (int m = 0; m < 4; ++m) { const int row = rowb + ai * 128 + m * 16; const float sc = rss ? rsqrtf((float)rss[row] * (RS_INV / 512.0f) + EPS) : 1.0f;
#pragma unroll
                for (int bj = 0; bj < 2; ++bj) { const int col = cl + bj * 128;
                    const f32x8 gt = unpack8(*(const u32x4*)(P + (size_t)row * NP + gcol + col));
                    f32x4 a0 = acc[ai][bj][m][0] * sc, a1 = acc[ai][bj][m][1] * sc;
#pragma unroll
                    for (int i = 0; i < 4; ++i) { a0[i] *= gt[i]; a1[i] *= gt[4 + i]; }
                    if (!first) { const f32x8 pv = unpack8(*(const u32x4*)(MIX + (size_t)row * DM + col));
#pragma unroll
                        for (int i = 0; i < 4; ++i) { a0[i] += pv[i]; a1[i] += pv[4 + i]; } }
                    *(u32x4*)(MIX + (size_t)row * DM + col) = pack8(a0, a1); } }
    }
};

struct TrSrc { int ld; int N; int mode; };
__device__ __forceinline__ const float* tr_col(const TrSrc& s, const float* W, const float* W2, int n) {
    if (s.mode == 0) return W + n;
    if (s.mode == 1) { const int j = (n >> 8) * 128 + (n & 127); const long d = ((n >> 7) & 1) ? (long)(W2 - W) : 0l; return W + d + j; }
    int src;
    if (n < 1280) src = n;
    else if (n < 1792) { const int j = n - 1280; if (j < 384) src = 1296 + j; else if (j < 400) src = 1280 + (j - 384); else return nullptr; }
    else if (n < 2816) { int hc = n - 1792; const int isk = hc >= 512; hc &= 511; const int hh = hc >> 6, c = hc & 63; const int d = 4 * (c >> 3) + (c & 3) + 32 * ((c >> 2) & 1); src = (isk ? 2192 : 1680) + hh * 64 + d; }
    else if (n < 3328) src = 2704 + (n - 2816);
    else if (n < 3840) src = 3216 + (n - 3328);
    else src = 3728 + (n - 3840);
    return W + src;
}
__device__ __forceinline__ void tr_item(const float* W, const float* W2, const float* gain, const TrSrc s, int K, bf16_t* WT, LAS float* scr, int item, int lane) {
    const int nblk = s.N / 32, kb = item / nblk, nb = item % nblk, k0 = 64 * kb, n0 = 32 * nb;
    const float* col = tr_col(s, W, W2, n0 + (lane & 31));
    float tv[32];
#pragma unroll
    for (int i = 0; i < 32; ++i) { const int kk = 2 * i + (lane >> 5); tv[i] = col ? col[(size_t)(k0 + kk) * s.ld] : 0.f; }
#pragma unroll
    for (int i = 0; i < 32; ++i) { const int kk = 2 * i + (lane >> 5); float v = tv[i]; if (gain) v *= gain[k0 + kk]; scr[kk * 33 + (lane & 31)] = v; }
    asm volatile("s_waitcnt lgkmcnt(0)" ::: "memory");
    const int c = lane & 7;
#pragma unroll
    for (int j = 0; j < 4; ++j) { const int n = (lane >> 3) + 8 * j; const LAS float* sp = scr + (8 * c) * 33 + n;
        u32x4 o; o.x = cvt_pk_bf16(sp[0 * 33], sp[1 * 33]); o.y = cvt_pk_bf16(sp[2 * 33], sp[3 * 33]); o.z = cvt_pk_bf16(sp[4 * 33], sp[5 * 33]); o.w = cvt_pk_bf16(sp[6 * 33], sp[7 * 33]);
        *(u32x4*)(WT + (size_t)(n0 + n) * K + k0 + 8 * c) = o; }
    asm volatile("s_waitcnt lgkmcnt(0)" ::: "memory");
}

struct S5P { const float *lre, *lim, *lstep, *bre, *bim, *cre, *cim, *d; };
__device__ __forceinline__ void s5_lam(const S5P& p, int dir, int g, int pp, float& lre, float& lim, float& step) {
    lre = fminf(p.lre[(dir * 24 + g) * 64 + pp], -1e-4f); lim = p.lim[(dir * 24 + g) * 64 + pp]; step = __expf(p.lstep[dir * 24 + g]);
}
__device__ __forceinline__ void cpowf_(float lre, float lim, float step, float tau, float& re, float& im) {
    const float mag = __expf(lre * step * tau); const float ang = lim * step * tau; float s, c; sincos_rev(ang * 0.15915494309189535f, s, c); re = mag * c; im = mag * s;
}
__device__ __forceinline__ void s5_coef(float lre, float lim, float step, float& cr, float& ci) {
    float lbr, lbi; cpowf_(lre, lim, step, 1.0f, lbr, lbi); const float nr = lbr - 1.0f, den = lre * lre + lim * lim;
    const float rd = rcpf_(den); cr = (nr * lre + lbi * lim) * rd; ci = (lbi * lre - nr * lim) * rd;
}

struct LaCtx { const bf16_t* P; const float* DT; bf16_t* ST; float* DEC; bf16_t* YA; bf16_t* YC; u64_t* rss; const float* conv_w; const float* conv_b; const float* dt_bias; const float* a_log; const float* dskip; };
constexpr int LA_F32 = 107520;
__device__ __forceinline__ f32x8 la_fetch8(LAS unsigned char* lds, const LaCtx& c, int m, int kind, int h, int row, int c8) {
    if (m == 1) { const int col = (kind == 0 ? PC_V : (kind == 1 ? PC_K : PC_Q)) + h * 64 + c8; return unpack8(*(const u32x4*)(c.P + (size_t)row * NP + col)); }
    const int ch = (kind == 0) ? (h * 64 + c8) : ((kind == 1 ? 512 : 640) + (h >> 2) * 64 + c8);
    const int pos = row & (SEQ - 1);
    const LAS float* cwl = (const LAS float*)(lds + LA_F32 + 4096) + ch;
    f32x8 a; { const f32x4 t0 = *(const LAS f32x4*)(cwl + 3840), t1 = *(const LAS f32x4*)(cwl + 3844); a[0] = t0[0]; a[1] = t0[1]; a[2] = t0[2]; a[3] = t0[3]; a[4] = t1[0]; a[5] = t1[1]; a[6] = t1[2]; a[7] = t1[3]; }
#pragma unroll
    for (int j = 0; j < 5; ++j) { const int pp = pos + j - 2;
        if ((unsigned)pp < (unsigned)SEQ) { const f32x8 v = unpack8(*(const u32x4*)(c.P + (size_t)(row + j - 2) * NP + PC_XBC + ch));
            const f32x4 w0 = *(const LAS f32x4*)(cwl + j * 768), w1 = *(const LAS f32x4*)(cwl + j * 768 + 4);
#pragma unroll
            for (int e = 0; e < 4; ++e) { a[e] += w0[e] * v[e]; a[4 + e] += w1[e] * v[4 + e]; } } }
#pragma unroll
    for (int e = 0; e < 8; ++e) a[e] = siluf_(a[e]);
    return a;
}
__device__ __forceinline__ void la_stage_conv_all(LAS unsigned char* lds, const LaCtx& c, int tid) {
    LAS float* cwl = (LAS float*)(lds + LA_F32 + 4096);
    for (int i = tid; i < 4608; i += 512) cwl[i] = (i < 3840) ? c.conv_w[i] : c.conv_b[i - 3840];
    __syncthreads();
}
__device__ __forceinline__ void la_cs(LAS unsigned char* lds, const LaCtx& c, int m, int h, int rowbase, int wave, int lane) {
    LAS float* cs0 = (LAS float*)(lds + LA_F32); LAS float* ce1 = cs0 + 128; LAS float* dtf = ce1 + 132; LAS float* dtb = dtf + 128; LAS float* dg = dtb + 128;
    if (wave >= 2) return;
    const int t0 = 2 * lane; float d0a = 1.f, d0b = 1.f, d1a = 1.f, d1b = 1.f, x0, x1, dga = 1.f, dgb = 1.f;
    if (m == 0) {
        d0a = softplusf_(c.DT[(size_t)(rowbase + t0) * 16 + h] + c.dt_bias[h]); d0b = softplusf_(c.DT[(size_t)(rowbase + t0 + 1) * 16 + h] + c.dt_bias[h]);
        d1a = softplusf_(c.DT[(size_t)(rowbase + t0) * 16 + 8 + h] + c.dt_bias[8 + h]); d1b = softplusf_(c.DT[(size_t)(rowbase + t0 + 1) * 16 + 8 + h] + c.dt_bias[8 + h]);
        const float A = -__expf(c.a_log[wave * 8 + h]);
        x0 = (wave == 0 ? d0a : d1a) * A; x1 = (wave == 0 ? d0b : d1b) * A;
        dga = d0a + d1a; dgb = d0b + d1b;
    } else { const float e_ = __builtin_amdgcn_ldexpf(1.0f, -5 - h); const float lg = -(e_ + e_ * e_ * (0.5f + e_ * (0.33333334f + 0.25f * e_))); x0 = lg; x1 = lg; }
    const float pair = x0 + x1; float inc = pair;
#pragma unroll
    for (int off = 1; off < 64; off <<= 1) { const float v = __builtin_bit_cast(float, __builtin_amdgcn_ds_bpermute((lane - off) << 2, __builtin_bit_cast(int, inc))); if (lane >= off) inc += v; }
    const float exc = inc - pair;
    if (wave == 0) { cs0[t0] = exc + x0; cs0[t0 + 1] = inc; dtf[t0] = d0a; dtf[t0 + 1] = d0b; dg[t0] = dga; dg[t0 + 1] = dgb; }
    else { ce1[t0] = exc; ce1[t0 + 1] = exc + x0; if (lane == 63) ce1[128] = inc; dtb[t0] = d1a; dtb[t0 + 1] = d1b; }
}
#define MFMA16(a, b, c) __builtin_amdgcn_mfma_f32_16x16x32_bf16(a, b, c, 0, 0, 0)
__device__ __forceinline__ int tsw(int row, int s) { return (((s >> 3) ^ ((row >> 3) & 7)) << 3) | (s & 7); }
__device__ __forceinline__ void la_unit_A(LAS unsigned char* lds, const LaCtx c, int m, int bb, int ci, int h, int tid) {
    const int wave = __builtin_amdgcn_readfirstlane(tid >> 6), lane = tid & 63;
    LAS float* cs0 = (LAS float*)(lds + LA_F32); LAS float* ce1 = cs0 + 128; LAS float* dtf = ce1 + 132; LAS float* dtb = dtf + 128;
    const int rowbase = bb * SEQ + ci * 128;
    la_cs(lds, c, m, h, rowbase, wave, lane);
    __syncthreads();
    const float csl = cs0[127];
#pragma unroll
    for (int it = 0; it < 2; ++it) { const int idx = tid + it * 512; const int s = idx >> 3, c8 = (idx & 7) * 8;
        const f32x8 x = la_fetch8(lds, c, m, 0, h, rowbase + s, c8), b = la_fetch8(lds, c, m, 1, h, rowbase + s, c8);
        const float wf = __expf(csl - cs0[s]) * dtf[s], wb = __expf(ce1[s]) * dtb[s];
        const int sw = tsw(c8, s);
        LAS bf16_t* xt = (LAS bf16_t*)(lds) + c8 * 136 + sw; LAS bf16_t* bf = (LAS bf16_t*)(lds + 17408) + c8 * 136 + sw; LAS bf16_t* bk = (LAS bf16_t*)(lds + 34816) + c8 * 136 + sw;
#pragma unroll
        for (int e = 0; e < 8; ++e) { xt[e * 136] = (bf16_t)f2bf(x[e]); bf[e * 136] = (bf16_t)f2bf(b[e] * wf); bk[e * 136] = (bf16_t)f2bf(b[e] * wb); } }
    if (tid < 2) c.DEC[((((m * 2 + bb) * 8 + h) * 2 + tid) * 64) + ci] = (tid == 0) ? __expf(csl) : __expf(ce1[128]);
    __syncthreads();
    const int dir = wave >> 2, nb = wave & 3, q = lane >> 4, r16 = lane & 15;
    LAS unsigned char* Bt = lds + 17408 + dir * 17408;
    bf16x8 af[4];
#pragma unroll
    for (int ks = 0; ks < 4; ++ks) af[ks] = *(const LAS bf16x8*)(Bt + ((16 * nb + r16) * 136 + tsw(16 * nb + r16, 32 * ks + 8 * q)) * 2);
    bf16_t* stb = c.ST + ((size_t)((((m * 2 + bb) * 8 + h) * 2 + dir) * 64 + ci)) * 4096;
#pragma unroll
    for (int pb = 0; pb < 4; ++pb) { f32x4 acc = (f32x4){0.f, 0.f, 0.f, 0.f};
#pragma unroll
        for (int ks = 0; ks < 4; ++ks) { const bf16x8 bfr = *(const LAS bf16x8*)(lds + ((16 * pb + r16) * 136 + tsw(16 * pb + r16, 32 * ks + 8 * q)) * 2); acc = MFMA16(af[ks], bfr, acc); }
        u32x2 w; w.x = cvt_pk_bf16(acc[0], acc[1]); w.y = cvt_pk_bf16(acc[2], acc[3]);
        *(u32x2*)(stb + (16 * pb + r16) * 64 + 16 * nb + 4 * q) = w; }
    __syncthreads();
}
__device__ __forceinline__ void la_unit_C(LAS unsigned char* lds, const LaCtx c, int m, int bb, int ci, int h, int tid, int grow0) {
    const int wave = __builtin_amdgcn_readfirstlane(tid >> 6), lane = tid & 63;
    LAS float* cs0 = (LAS float*)(lds + LA_F32); LAS float* ce1 = cs0 + 128; LAS float* dtf = ce1 + 132; LAS float* dtb = dtf + 128; LAS float* dg = dtb + 128;
    constexpr int O_CQ = 0, O_BK = 18432, O_XT = 36864, O_P = 54272, O_SF = 89088, O_SB = 98304;
    const int rowbase = bb * SEQ + ci * 128;
    la_cs(lds, c, m, h, rowbase, wave, lane);
#pragma unroll
    for (int it = 0; it < 2; ++it) { const int idx = tid + it * 512; const int s = idx >> 3, c8 = (idx & 7) * 8;
        const f32x8 x = la_fetch8(lds, c, m, 0, h, rowbase + s, c8), b = la_fetch8(lds, c, m, 1, h, rowbase + s, c8), qv = la_fetch8(lds, c, m, 2, h, rowbase + s, c8);
        u32x4 wq, wb;
        wq.x = cvt_pk_bf16(qv[0], qv[1]); wq.y = cvt_pk_bf16(qv[2], qv[3]); wq.z = cvt_pk_bf16(qv[4], qv[5]); wq.w = cvt_pk_bf16(qv[6], qv[7]);
        wb.x = cvt_pk_bf16(b[0], b[1]); wb.y = cvt_pk_bf16(b[2], b[3]); wb.z = cvt_pk_bf16(b[4], b[5]); wb.w = cvt_pk_bf16(b[6], b[7]);
        *(LAS u32x4*)(lds + O_CQ + (s * 72 + c8) * 2) = wq; *(LAS u32x4*)(lds + O_BK + (s * 72 + c8) * 2) = wb;
        LAS bf16_t* xt = (LAS bf16_t*)(lds + O_XT) + c8 * 136 + tsw(c8, s);
#pragma unroll
        for (int e = 0; e < 8; ++e) xt[e * 136] = (bf16_t)f2bf(x[e]); }
    { const bf16_t* sf = c.ST + ((size_t)((((m * 2 + bb) * 8 + h) * 2 + 0) * 64 + ci)) * 4096 + tid * 8; const bf16_t* sb = sf + (size_t)64 * 4096;
      const int p = tid >> 3, n8 = (tid & 7) * 8;
      *(LAS u32x4*)(lds + O_SF + (p * 72 + n8) * 2) = *(const u32x4*)sf; *(LAS u32x4*)(lds + O_SB + (p * 72 + n8) * 2) = *(const u32x4*)sb; }
    __syncthreads();
    const int q = lane >> 4, r16 = lane & 15; const int t = 16 * wave + r16;
    u32x2 zg[4];
#pragma unroll
    for (int pb = 0; pb < 4; ++pb) zg[pb] = *(const u32x2*)(c.P + (size_t)(rowbase + t) * NP + (m == 0 ? PC_Z : PC_G) + h * 64 + 16 * pb + 4 * q);
    bf16x8 bq[2];
#pragma unroll
    for (int ks = 0; ks < 2; ++ks) bq[ks] = *(const LAS bf16x8*)(lds + O_CQ + (t * 72 + 32 * ks + 8 * q) * 2);
    const float cs0_t = cs0[t], ce1_t = ce1[t], dg_t = dg[t];
#pragma unroll
    for (int sb = 0; sb < 8; ++sb) { f32x4 acc = (f32x4){0.f, 0.f, 0.f, 0.f};
#pragma unroll
        for (int ks = 0; ks < 2; ++ks) { const bf16x8 a = *(const LAS bf16x8*)(lds + O_BK + ((16 * sb + r16) * 72 + 32 * ks + 8 * q) * 2); acc = MFMA16(a, bq[ks], acc); }
        const int s0 = 16 * sb + 4 * q;
        const f32x4 c0 = *(const LAS f32x4*)(cs0 + s0), e1 = *(const LAS f32x4*)(ce1 + s0), df = *(const LAS f32x4*)(dtf + s0), db = *(const LAS f32x4*)(dtb + s0);
        float pv[4];
#pragma unroll
        for (int r = 0; r < 4; ++r) { const int s = s0 + r; const float arg = (s < t) ? (cs0_t - c0[r]) : (e1[r] - ce1_t);
            float w = __expf(arg) * ((s < t) ? df[r] : db[r]); if (s == t) w = dg_t; pv[r] = acc[r] * w; }
        u32x2 w2; w2.x = cvt_pk_bf16(pv[0], pv[1]); w2.y = cvt_pk_bf16(pv[2], pv[3]);
        *(LAS u32x2*)(lds + O_P + (t * 136 + s0) * 2) = w2; }
    __syncthreads();
    f32x4 aY[4], aF[4], aB[4];
#pragma unroll
    for (int pb = 0; pb < 4; ++pb) { aY[pb] = (f32x4){0.f, 0.f, 0.f, 0.f}; aF[pb] = aY[pb]; aB[pb] = aY[pb]; }
#pragma unroll
    for (int ks = 0; ks < 4; ++ks) { const bf16x8 bp = *(const LAS bf16x8*)(lds + O_P + (t * 136 + 32 * ks + 8 * q) * 2);
#pragma unroll
        for (int pb = 0; pb < 4; ++pb) { const bf16x8 a = *(const LAS bf16x8*)(lds + O_XT + ((16 * pb + r16) * 136 + tsw(16 * pb + r16, 32 * ks + 8 * q)) * 2); aY[pb] = MFMA16(a, bp, aY[pb]); } }
#pragma unroll
    for (int ks = 0; ks < 2; ++ks)
#pragma unroll
        for (int pb = 0; pb < 4; ++pb) { const bf16x8 a = *(const LAS bf16x8*)(lds + O_SF + ((16 * pb + r16) * 72 + 32 * ks + 8 * q) * 2); aF[pb] = MFMA16(a, bq[ks], aF[pb]);
            const bf16x8 a2 = *(const LAS bf16x8*)(lds + O_SB + ((16 * pb + r16) * 72 + 32 * ks + 8 * q) * 2); aB[pb] = MFMA16(a2, bq[ks], aB[pb]); }
    const float rf = __expf(cs0_t), rb = __expf(ce1[128] - ce1_t);
    const int row = rowbase + t;
    float ss = 0.f; f32x4 y[4];
#pragma unroll
    for (int pb = 0; pb < 4; ++pb) { y[pb] = aY[pb] + rf * aF[pb] + rb * aB[pb]; }
    if (m == 0) {
        const float dsk = c.dskip[h];
#pragma unroll
        for (int pb = 0; pb < 4; ++pb)
#pragma unroll
            for (int r = 0; r < 4; ++r) { const unsigned xv = *((const LAS bf16_t*)(lds + O_XT) + (16 * pb + 4 * q + r) * 136 + tsw(16 * pb + 4 * q + r, t)); y[pb][r] += dsk * __builtin_bit_cast(float, xv << 16); }
#pragma unroll
        for (int pb = 0; pb < 4; ++pb) { const int col = h * 64 + 16 * pb + 4 * q; const u32x2 zz = zg[pb];
            f32x4 o; o[0] = y[pb][0] * siluf_(bflo(zz.x)); o[1] = y[pb][1] * siluf_(bfhi(zz.x)); o[2] = y[pb][2] * siluf_(bflo(zz.y)); o[3] = y[pb][3] * siluf_(bfhi(zz.y));
            ss += (o[0] * o[0] + o[1] * o[1]) + (o[2] * o[2] + o[3] * o[3]);
            u32x2 w; w.x = cvt_pk_bf16(o[0], o[1]); w.y = cvt_pk_bf16(o[2], o[3]); *(u32x2*)(c.YA + (size_t)row * 512 + col) = w; }
        ss += shflx(ss, 16, lane); ss += shflx(ss, 32, lane);
        if (q == 0) atomicAdd(c.rss + grow0 + row, (u64_t)(ss * RS_SCALE));
    } else {
#pragma unroll
        for (int pb = 0; pb < 4; ++pb) ss += (y[pb][0] * y[pb][0] + y[pb][1] * y[pb][1]) + (y[pb][2] * y[pb][2] + y[pb][3] * y[pb][3]);
        ss += shflx(ss, 16, lane); ss += shflx(ss, 32, lane);
        const float rstd = rsqrtf(ss * (1.0f / 64.0f) + EPS);
#pragma unroll
        for (int pb = 0; pb < 4; ++pb) { const int col = h * 64 + 16 * pb + 4 * q; const u32x2 gg = zg[pb];
            f32x4 o; o[0] = y[pb][0] * rstd * siluf_(bflo(gg.x)); o[1] = y[pb][1] * rstd * siluf_(bfhi(gg.x)); o[2] = y[pb][2] * rstd * siluf_(bflo(gg.y)); o[3] = y[pb][3] * rstd * siluf_(bfhi(gg.y));
            u32x2 w; w.x = cvt_pk_bf16(o[0], o[1]); w.y = cvt_pk_bf16(o[2], o[3]); *(u32x2*)(c.YC + (size_t)row * 512 + col) = w; }
    }
    __syncthreads();
}
__device__ __forceinline__ void la_scan_item(const LaCtx c, int item, int tid) {
    const int quarter = item & 3, seq = item >> 2;
    const int dir = seq & 1;
    unsigned* base = (unsigned*)(c.ST + (size_t)seq * 64 * 4096 + quarter * 1024) + tid;
    const float* dec = c.DEC + seq * 64;
    float s0 = 0.f, s1 = 0.f;
#pragma unroll 1
    for (int b = 0; b < 2; ++b) {
        unsigned r[32];
#pragma unroll
        for (int k = 0; k < 32; ++k) { const int o = b * 32 + k; const int ci = dir ? (63 - o) : o; r[k] = base[(size_t)ci * 2048]; }
#pragma unroll
        for (int k = 0; k < 32; ++k) { const int o = b * 32 + k; const int ci = dir ? (63 - o) : o; const float lo = bflo(r[k]), hi = bfhi(r[k]);
            base[(size_t)ci * 2048] = cvt_pk_bf16(s0, s1); const float d = dec[ci]; s0 = d * s0 + lo; s1 = d * s1 + hi; }
    }
}
__device__ __forceinline__ void s5_scan_item(LAS unsigned char* lds, const S5P p, const float* SC, bf16_t* UG, int item, int tid) {
    const int wave = __builtin_amdgcn_readfirstlane(tid >> 6), lane = tid & 63;
    const int dir = item & 1, g = (item >> 1) % 24, bb = item / 48;
    float lre, lim, step; s5_lam(p, dir, g, lane, lre, lim, step);
    float Lr, Li, Sr, Si; cpowf_(lre, lim, step, 16.0f, Lr, Li); cpowf_(lre, lim, step, 1024.0f, Sr, Si);
    const size_t rbase = (size_t)g * 1024 + bb * 512;
    float re[64], im[64];
#pragma unroll
    for (int k = 0; k < 64; ++k) { const int o = wave * 64 + k; const int ci = dir ? (511 - o) : o; const size_t row = rbase + ci;
        re[k] = SC[row * 256 + dir * 128 + lane]; im[k] = SC[row * 256 + dir * 128 + 64 + lane]; }
    float hr = 0.f, hi = 0.f;
#pragma unroll
    for (int k = 0; k < 64; ++k) { const float nr = Lr * hr - Li * hi + re[k], ni = Lr * hi + Li * hr + im[k]; hr = nr; hi = ni; }
    LAS float* totr = (LAS float*)lds; LAS float* toti = totr + 512;
    totr[wave * 64 + lane] = hr; toti[wave * 64 + lane] = hi;
    __syncthreads();
    float Hr = 0.f, Hi = 0.f;
#pragma unroll
    for (int j = 0; j < 7; ++j) if (j < wave) { const float tr = totr[j * 64 + lane], ti = toti[j * 64 + lane]; const float nr = Sr * Hr - Si * Hi + tr, ni = Sr * Hi + Si * Hr + ti; Hr = nr; Hi = ni; }
#pragma unroll
    for (int k = 0; k < 64; ++k) { const int o = wave * 64 + k; const int ci = dir ? (511 - o) : o; const size_t row = rbase + ci;
        UG[row * 512 + 256 + dir * 128 + lane] = (bf16_t)f2bf(Hr); UG[row * 512 + 256 + dir * 128 + 64 + lane] = (bf16_t)f2bf(Hi);
        const float nr = Lr * Hr - Li * Hi + re[k], ni = Lr * Hi + Li * Hr + im[k]; Hr = nr; Hi = ni; }
    __syncthreads();
}

constexpr size_t WS_BAR = 1 * MiB;
#define XB_TMO      128
#define XB_XCNT(j)  (256  + 64 * (j))
#define XB_XSUB(j)  (1280 + 64 * (j))
#define XB_XGEN(j)  (2304 + 64 * (j))
#define XB_TOP      3328
#define XB_TOPGEN   3392
#define XCD_BAR_WORDS 3456
#define XB_SPIN_CAP (1u << 22)
__device__ __forceinline__ unsigned xb_ld(unsigned* p)              { return __hip_atomic_load(p, __ATOMIC_RELAXED, __HIP_MEMORY_SCOPE_AGENT); }
__device__ __forceinline__ unsigned xb_add(unsigned* p, unsigned v) { return __hip_atomic_fetch_add(p, v, __ATOMIC_RELAXED, __HIP_MEMORY_SCOPE_AGENT); }
__device__ __forceinline__ unsigned xb_xcc_id() { return (unsigned)__builtin_amdgcn_s_getreg((3 << 11) | 20) & 0xFu; }
#define XB_SPIN(cond, bar) do { unsigned _sp = 0; while (cond) { __builtin_amdgcn_s_sleep(1); \
    if ((++_sp & 255u) == 0u) { if (xb_ld(&(bar)[XB_TMO])) break; if (_sp > XB_SPIN_CAP) { atomicAdd(&(bar)[XB_TMO], 1u); break; } } } } while (0)
__device__ __forceinline__ void xcd_barrier_complete(unsigned* bar, unsigned x, unsigned G, unsigned& nloc, unsigned& nx) {
    unsigned sum, cnt, mine, sp = 0u;
    for (;;) {
        sum = 0u; cnt = 0u; mine = 0u;
#pragma unroll
        for (unsigned j = 0; j < 16; ++j) { const unsigned c = xb_ld(&bar[XB_XCNT(j)]); sum += c; cnt += (c > 0u) ? 1u : 0u; mine = (j == x) ? c : mine; }
        if (sum == G) break;
        __builtin_amdgcn_s_sleep(1);
        if ((++sp & 255u) == 0u) { if (xb_ld(&bar[XB_TMO])) break; if (sp > XB_SPIN_CAP) { atomicAdd(&bar[XB_TMO], 1u); break; } }
    }
    nloc = mine > 0u ? mine : 1u; nx = cnt > 0u ? cnt : 1u;
}
__device__ __forceinline__ void xcd_barrier(unsigned* bar, volatile LAS unsigned* st, bool t0, unsigned G) {
    asm volatile("s_waitcnt vmcnt(0)" ::: "memory");
    __syncthreads();
    if (t0) {
        const unsigned x = xb_xcc_id();
        __builtin_amdgcn_s_waitcnt(0);
        unsigned nloc = st[0], nx = st[1];
        if (nloc == 0u) { xcd_barrier_complete(bar, x, G, nloc, nx); st[0] = nloc; st[1] = nx; }
        const unsigned old = xb_add(&bar[XB_XSUB(x)], 1u);
        const unsigned gen = old / nloc;
        if (old + 1u == (gen + 1u) * nloc) {
            __builtin_amdgcn_fence(__ATOMIC_RELEASE, "agent");
            asm volatile("s_waitcnt vmcnt(0)" ::: "memory");
            const unsigned og = xb_add(&bar[XB_TOP], 1u);
            const unsigned tg = og / nx;
            if (og + 1u == (tg + 1u) * nx) xb_add(&bar[XB_TOPGEN], 1u);
            else XB_SPIN(xb_ld(&bar[XB_TOPGEN]) == tg, bar);
            __builtin_amdgcn_fence(__ATOMIC_ACQUIRE, "agent");
            xb_add(&bar[XB_XGEN(x)], 1u);
            asm volatile("s_waitcnt vmcnt(0)" ::: "memory");
        } else {
            XB_SPIN(xb_ld(&bar[XB_XGEN(x)]) == gen, bar);
            __builtin_amdgcn_fence(__ATOMIC_ACQUIRE, "agent");
            asm volatile("s_waitcnt vmcnt(0)" ::: "memory");
        }
    }
    __syncthreads();
}


__device__ __forceinline__ S5P make_s5p(KArgP ap, int layer) {
    S5P sp; sp.lre = ap->in[15] + layer * 3072; sp.lim = ap->in[16] + layer * 3072; sp.lstep = ap->in[17] + layer * 48; sp.bre = ap->in[18] + layer * 24576; sp.bim = ap->in[19] + layer * 24576;
    sp.cre = ap->in[20] + layer * 49152; sp.cim = ap->in[21] + layer * 49152; sp.d = ap->in[22] + layer * 384; return sp;
}
__device__ __forceinline__ LaCtx make_lactx(KArgP ap, unsigned char* ws, int layer) {
    LaCtx lc; lc.P = WSP(bf16_t, WS_P); lc.DT = WSP(float, WS_DT); lc.ST = WSP(bf16_t, WS_ST); lc.DEC = WSP(float, WS_DEC); lc.YA = WSP(bf16_t, WS_YA); lc.YC = WSP(bf16_t, WS_YC);
    lc.rss = WSP(u64_t, WS_RS) + (size_t)(7 + layer) * T_ALL;
    lc.conv_w = ap->in[8] + layer * 5 * 768; lc.conv_b = ap->in[9] + layer * 768; lc.dt_bias = ap->in[10] + layer * 16; lc.a_log = ap->in[11] + layer * 16; lc.dskip = ap->in[12] + layer * 8;
    return lc;
}

__global__ void __launch_bounds__(512, 2) mega_fwd(Args a_unused) {
    extern __shared__ __attribute__((aligned(16))) unsigned char lds_raw[];
    LAS unsigned char* lds0 = (LAS unsigned char*)lds_raw;
    cg::grid_group grid = cg::this_grid();
#define GSYNC() do { PHASE(); TID_LOCAL(); xcd_barrier(WSP(unsigned, WS_BAR), (volatile LAS unsigned*)(lds + 131072 + 512), tid == 0, (unsigned)G); } while (0)
    const int wave0 = __builtin_amdgcn_readfirstlane((int)threadIdx.x >> 6);
    { if (threadIdx.x < 2) ((volatile LAS unsigned*)(lds0 + 131072 + 512))[threadIdx.x] = 0u; __syncthreads();
      KArgP ap0 = (KArgP)__builtin_amdgcn_kernarg_segment_ptr(); unsigned* bar0 = (unsigned*)(ap0->ws + WS_BAR); if (threadIdx.x == 0) (void)xb_add(&bar0[XB_XCNT(xb_xcc_id())], 1u);
      grid.sync(); }

    { PHASE(); TID_LOCAL();
      u64_t* RS = WSP(u64_t, WS_RS); bf16_t* XB = WSP(bf16_t, WS_XB); float* ROPEC = WSP(float, WS_ROPE); float* ROPES = ROPEC + SEQ * 32; const float* xin = ap->in[0];
      for (int m = gw; m < T_ALL; m += 2 * NGW) {
        const int m2 = m + NGW; const bool has2 = m2 < T_ALL;
        const float* xr = xin + (size_t)m * DM + lane; const float* xr2 = xin + (size_t)(has2 ? m2 : m) * DM + lane;
        float va[16], vb[16];
#pragma unroll
        for (int j = 0; j < 16; ++j) { va[j] = xr[64 * j]; vb[j] = xr2[64 * j]; }
        bf16_t* xb = XB + (size_t)m * DM + lane; bf16_t* xb2 = XB + (size_t)m2 * DM + lane; float s = 0.f, s2 = 0.f;
#pragma unroll
        for (int j = 0; j < 16; ++j) { s += va[j] * va[j]; xb[64 * j] = (bf16_t)f2bf(va[j]); s2 += vb[j] * vb[j]; if (has2) xb2[64 * j] = (bf16_t)f2bf(vb[j]); }
        s = wave_sum(s, lane); s2 = wave_sum(s2, lane);
        if (lane == 0) { RS[m] = (u64_t)(s * RS_SCALE); if (has2) RS[m2] = (u64_t)(s2 * RS_SCALE); }
      }
      for (int i = gt; i < 8 * T_ALL; i += NGT) RS[T_ALL + i] = 0ull;
      for (int i = gt; i < SEQ * 32; i += NGT) { const int pos = i >> 5, j = i & 31; double inv = 1.0; for (int q = 0; q < j; ++q) inv *= 0.74989420933245582730; const double rev = (double)pos * inv * 0.15915494309189533577; const float fr_ = (float)(rev - floor(rev)); ROPEC[i] = __builtin_amdgcn_cosf(fr_); ROPES[i] = __builtin_amdgcn_sinf(fr_); }
    }

    for (int layer = 0; layer < 2; ++layer) {
        { PHASE(); TID_LOCAL();
            LAS float* scr = (LAS float*)(lds + wave * 16384);
            constexpr int I_GU = 16 * 176, I_D = 44 * 32, I_IN = 16 * 216, I_A = 8 * 32, I_B = 6 * 32, I_GLU = 6 * 24, I_C = 8 * 32, I_O = 16 * 32;
            constexpr int NITEMS = 2 * I_GU + 2 * I_D + I_IN + I_A + I_B + I_GLU + I_C + I_O;
            for (int it = gw; it < NITEMS; it += NGW) {
                int r = it;
                if (r < I_GU) { TrSrc s{FF, 2 * FF, 1}; tr_item(ap->in[2] + (size_t)layer * DM * FF, ap->in[3] + (size_t)layer * DM * FF, ap->in[1] + layer * DM, s, DM, WSP(bf16_t, WS_WGU1), scr, r, lane); continue; } r -= I_GU;
                if (r < I_GU) { TrSrc s{FF, 2 * FF, 1}; tr_item(ap->in[30] + (size_t)layer * DM * FF, ap->in[31] + (size_t)layer * DM * FF, ap->in[29] + layer * DM, s, DM, WSP(bf16_t, WS_WGU2), scr, r, lane); continue; } r -= I_GU;
                if (r < I_D) { TrSrc s{DM, DM, 0}; tr_item(ap->in[4] + (size_t)layer * DM * FF, nullptr, nullptr, s, FF, WSP(bf16_t, WS_WD1), scr, r, lane); continue; } r -= I_D;
                if (r < I_D) { TrSrc s{DM, DM, 0}; tr_item(ap->in[32] + (size_t)layer * DM * FF, nullptr, nullptr, s, FF, WSP(bf16_t, WS_WD2), scr, r, lane); continue; } r -= I_D;
                if (r < I_IN) { TrSrc s{6800, NP, 2}; tr_item(ap->in[6] + (size_t)layer * DM * 6800, nullptr, ap->in[5] + layer * DM, s, DM, WSP(bf16_t, WS_WIN), scr, r, lane); continue; } r -= I_IN;
                if (r < I_A) { TrSrc s{DM, DM, 0}; tr_item(ap->in[14] + (size_t)layer * 512 * DM, nullptr, ap->in[13] + layer * 512, s, 512, WSP(bf16_t, WS_WA), scr, r, lane); continue; } r -= I_A;
                if (r < I_B) { TrSrc s{DM, DM, 0}; tr_item(ap->in[25] + (size_t)layer * 384 * DM, nullptr, nullptr, s, 384, WSP(bf16_t, WS_WB), scr, r, lane); continue; } r -= I_B;
                if (r < I_GLU) { TrSrc s{384, 768, 1}; tr_item(ap->in[23] + (size_t)layer * 384 * 384, ap->in[24] + (size_t)layer * 384 * 384, nullptr, s, 384, WSP(bf16_t, WS_WGLU), scr, r, lane); continue; } r -= I_GLU;
                if (r < I_C) { TrSrc s{DM, DM, 0}; tr_item(ap->in[27] + (size_t)layer * 512 * DM, nullptr, ap->in[26] + layer * 512, s, 512, WSP(bf16_t, WS_WC), scr, r, lane); continue; } r -= I_C;
                { TrSrc s{DM, DM, 0}; tr_item(ap->in[28] + (size_t)layer * DM * DM, nullptr, nullptr, s, DM, WSP(bf16_t, WS_WOUT), scr, r, lane); }
            }
        }
        { PHASE(); TID_LOCAL(); const S5P sp = make_s5p(ap, layer); float* KTAB = WSP(float, WS_KTAB);
            for (int i = gt; i < 24 * 2 * 16 * 256; i += NGT) {
                const int cc = i & 15, c = (i >> 4) & 15, tau = (i >> 8) & 15, dir = (i >> 12) & 1, g = i >> 13; float sum = 0.f;
                for (int pp = 0; pp < 64; ++pp) { float lre, lim, step; s5_lam(sp, dir, g, pp, lre, lim, step); float cr, ci; s5_coef(lre, lim, step, cr, ci);
                    float pr, pi; cpowf_(lre, lim, step, (float)tau, pr, pi); const float mr = pr * cr - pi * ci, mi = pr * ci + pi * cr;
                    const float br = sp.bre[(g * 64 + pp) * 16 + cc], bi = sp.bim[(g * 64 + pp) * 16 + cc]; const float mbr = mr * br - mi * bi, mbi = mr * bi + mi * br;
                    const float c_r = sp.cre[((dir * 24 + g) * 16 + c) * 64 + pp], c_i = sp.cim[((dir * 24 + g) * 16 + c) * 64 + pp];
                    sum += c_r * mbr - c_i * mbi; }
                KTAB[i] = sum;
            }
        }
        { PHASE(); TID_LOCAL(); const S5P sp = make_s5p(ap, layer); bf16_t* S5S = WSP(bf16_t, WS_S5S); bf16_t* S5Y = WSP(bf16_t, WS_S5Y);
            for (int i = gt; i < 24 * 256 * 256; i += NGT) {
                const int k = i & 255, n = (i >> 8) & 255, g = i >> 16;
                { const int s = k >> 4, cc = k & 15; const int dir = n >> 7, isim = (n >> 6) & 1, pp = n & 63; const float tau = dir == 0 ? (float)(15 - s) : (float)s;
                  float lre, lim, step; s5_lam(sp, dir, g, pp, lre, lim, step); float cr, ci; s5_coef(lre, lim, step, cr, ci); float pr, pi; cpowf_(lre, lim, step, tau, pr, pi);
                  const float mr = pr * cr - pi * ci, mi = pr * ci + pi * cr; const float br = sp.bre[(g * 64 + pp) * 16 + cc], bi = sp.bim[(g * 64 + pp) * 16 + cc];
                  const float val = isim ? (mr * bi + mi * br) : (mr * br - mi * bi); S5S[i] = (bf16_t)f2bf(val); }
                { const int t = n >> 4, c = n & 15; const int dir = k >> 7, isim = (k >> 6) & 1, pp = k & 63; const float tau = dir == 0 ? (float)(t + 1) : (float)(16 - t);
                  float lre, lim, step; s5_lam(sp, dir, g, pp, lre, lim, step); float pr, pi; cpowf_(lre, lim, step, tau, pr, pi);
                  const float c_r = sp.cre[((dir * 24 + g) * 16 + c) * 64 + pp], c_i = sp.cim[((dir * 24 + g) * 16 + c) * 64 + pp];
                  const float val = isim ? -(c_r * pi + c_i * pr) : (c_r * pr - c_i * pi); S5Y[((size_t)(g * 256 + n)) * 512 + 256 + k] = (bf16_t)f2bf(val); }
            }
        }
        GSYNC();
        { PHASE(); TID_LOCAL(); const float* KTAB = WSP(float, WS_KTAB); bf16_t* S5Y = WSP(bf16_t, WS_S5Y); const float* dd = ap->in[22] + layer * 384;
        for (int i = gt; i < 24 * 256 * 256; i += NGT) {
            const int k = i & 255, n = (i >> 8) & 255, g = i >> 16; const int s = k >> 4, cc = k & 15, t = n >> 4, c = n & 15; float v = 0.f;
            if (t >= s) v += KTAB[(((g * 2 + 0) * 16 + (t - s)) * 16 + c) * 16 + cc];
            if (s >= t) v += KTAB[(((g * 2 + 1) * 16 + (s - t)) * 16 + c) * 16 + cc];
            if (s == t && c == cc) v += dd[g * 16 + c];
            S5Y[((size_t)(g * 256 + n)) * 512 + k] = (bf16_t)f2bf(v);
        } }

        for (int f = 0; f < 2; ++f) {
            const int sidx = layer * 2 + f;
            const int rs_in = (sidx == 0) ? 0 : (sidx == 1 ? 2 : (sidx == 2 ? 3 : 5));
            const int rs_out = rs_in + 1;
            { PHASE(); TID_LOCAL(); pg8::Gemm g{WSP(bf16_t, WS_XB), WSP(bf16_t, f ? WS_WGU2 : WS_WGU1), DM, DM, DM}; pg8::SchedFull S; S.init(T_ALL / 256, 2 * FF / 256, G, bid);
              EpiGU E{rs_in}; pg8::gemm_phase(lds, g, S, E, tid); }
            GSYNC();
            { PHASE(); TID_LOCAL(); pg8::Gemm g{WSP(bf16_t, WS_H), WSP(bf16_t, f ? WS_WD2 : WS_WD1), FF, FF, FF}; pg8::SchedFull S; S.init(T_ALL / 256, DM / 256, G, bid);
              EpiRes E{(sidx == 0) ? 1 : 0, 0, rs_out, 0.5f}; pg8::gemm_phase(lds, g, S, E, tid); }
            GSYNC();
            if (f == 1) break;
            const int rs_b = rs_out, rs_c = rs_out + 1;
            for (int half = 0; half < 2; ++half) {
                const int row0 = half * TH;
                { PHASE(); TID_LOCAL(); pg8::Gemm g{WSP(bf16_t, WS_XB) + (size_t)row0 * DM, WSP(bf16_t, WS_WIN), DM, DM, DM}; pg8::SchedFull S; S.init(TH / 256, NP / 256, G, bid);
                  EpiInproj E{row0, rs_b, layer};
                  pg8::gemm_phase(lds, g, S, E, tid); }
                GSYNC();
                { PHASE(); TID_LOCAL(); pg8::Gemm g{WSP(bf16_t, WS_UG), WSP(bf16_t, WS_S5S), 512, 256, 256}; pg8::SchedGrp S; S.init(4, 1, 24, G, bid); EpiS5S E{0}; pg8::gemm_phase(lds, g, S, E, tid); }
                { PHASE(); TID_LOCAL(); const LaCtx lc = make_lactx(ap, ws, layer); la_stage_conv_all(lds, lc, tid);
                  for (int un = bid; un < 2048; un += G) { const int h = un & 7, ci = (un >> 3) & 63, bb = (un >> 9) & 1, m = un >> 10; la_unit_A(lds, lc, m, bb, ci, h, tid); } }
                GSYNC();
                { PHASE(); TID_LOCAL(); const LaCtx lc = make_lactx(ap, ws, layer);
                  for (int it = bid; it < 256; it += G) la_scan_item(lc, it, tid); }
                { PHASE(); TID_LOCAL(); const S5P sp = make_s5p(ap, layer);
                  for (int it = bid; it < 96; it += G) s5_scan_item(lds, sp, WSP(float, WS_SC), WSP(bf16_t, WS_UG), it, tid); }
                GSYNC();
                { PHASE(); TID_LOCAL(); pg8::Gemm g{WSP(bf16_t, WS_UG), WSP(bf16_t, WS_S5Y), 512, 512, 512}; pg8::SchedGrp S; S.init(4, 1, 24, G, bid); EpiS5Y E{0}; pg8::gemm_phase(lds, g, S, E, tid); }
                { PHASE(); TID_LOCAL(); const LaCtx lc = make_lactx(ap, ws, layer); la_stage_conv_all(lds, lc, tid);
                  for (int un = bid; un < 2048; un += G) { const int h = un & 7, ci = (un >> 3) & 63, bb = (un >> 9) & 1, m = un >> 10; la_unit_C(lds, lc, m, bb, ci, h, tid, row0); } }
                GSYNC();
                { PHASE(); TID_LOCAL(); pg8::Gemm g{WSP(bf16_t, WS_P) + PC_YBP, WSP(bf16_t, WS_WGLU), NP, 384, 384}; pg8::SchedFull S; S.init(TH / 256, 3, G, bid); EpiGLU E{0}; pg8::gemm_phase(lds, g, S, E, tid); }
                GSYNC();
                { PHASE(); TID_LOCAL(); pg8::SchedFull S; S.init(TH / 256, DM / 256, G, bid);
                  pg8::Gemm g{WSP(bf16_t, WS_YA), WSP(bf16_t, WS_WA), 512, 512, 512}; EpiBr E{PC_GATE, (7 + layer) * T_ALL + row0, 1}; pg8::gemm_phase(lds, g, S, E, tid); }
                { PHASE(); TID_LOCAL(); pg8::SchedFull S; S.init(TH / 256, DM / 256, G, bid);
                  pg8::Gemm g{WSP(bf16_t, WS_YB), WSP(bf16_t, WS_WB), 384, 384, 384}; EpiBr E{PC_GATE + 1024, -1, 0}; pg8::gemm_phase(lds, g, S, E, tid); }
                { PHASE(); TID_LOCAL(); pg8::SchedFull S; S.init(TH / 256, DM / 256, G, bid);
                  pg8::Gemm g{WSP(bf16_t, WS_YC), WSP(bf16_t, WS_WC), 512, 512, 512}; EpiBr E{PC_GATE + 2048, -1, 0}; pg8::gemm_phase(lds, g, S, E, tid); }
                GSYNC();
                { PHASE(); TID_LOCAL(); pg8::Gemm g{WSP(bf16_t, WS_MIX), WSP(bf16_t, WS_WOUT), DM, DM, DM}; pg8::SchedFull S; S.init(TH / 256, DM / 256, G, bid);
                  EpiRes E{0, row0, rs_c, 1.0f}; pg8::gemm_phase(lds, g, S, E, tid); }
                GSYNC();
            }
        }
    }
    { PHASE(); TID_LOCAL(); float* xout = ap->out; const u64_t* RS6 = WSP(u64_t, WS_RS) + (size_t)6 * T_ALL; const float* fn = ap->in[33]; const bf16_t* XB = WSP(bf16_t, WS_XB);
    for (int m = gw; m < T_ALL; m += NGW) {
        f32x4* xr = (f32x4*)(xout + (size_t)m * DM) + lane; const u32x2* xb = (const u32x2*)(XB + (size_t)m * DM) + lane; const float* gn = fn + 4 * lane;
        const float rstd = rsqrtf((float)RS6[m] * (RS_INV / DM) + EPS);
#pragma unroll
        for (int j = 0; j < 4; ++j) { const u32x2 w = xb[64 * j]; f32x4 v; v[0] = bflo(w.x); v[1] = bfhi(w.x); v[2] = bflo(w.y); v[3] = bfhi(w.y);
            f32x4 gg; gg[0] = gn[256 * j]; gg[1] = gn[256 * j + 1]; gg[2] = gn[256 * j + 2]; gg[3] = gn[256 * j + 3]; xr[64 * j] = v * rstd * gg; }
    } }
}

extern "C" void kernel_launch(void* const* d_in, const int* in_sizes, int n_in, void* d_out, int out_size, void* d_ws, size_t ws_size, hipStream_t stream) {
    static int grid = 0;
    if (grid == 0) {
        if (n_in != 34 || ws_size < WS_END) { fprintf(stderr, "kernel_launch: unexpected n_in %d / ws %zu (need %zu)\n", n_in, ws_size, (size_t)WS_END); grid = -1; return; }
        int dev = 0, cus = 0, per_cu = 0;
        (void)hipGetDevice(&dev); (void)hipDeviceGetAttribute(&cus, hipDeviceAttributeMultiprocessorCount, dev);
        if (hipFuncSetAttribute((const void*)mega_fwd, hipFuncAttributeMaxDynamicSharedMemorySize, LDS_BYTES) != hipSuccess) { fprintf(stderr, "kernel_launch: hipFuncSetAttribute failed\n"); grid = -1; return; }
        if (hipOccupancyMaxActiveBlocksPerMultiprocessor(&per_cu, (const void*)mega_fwd, 512, LDS_BYTES) != hipSuccess || per_cu < 1) { fprintf(stderr, "kernel_launch: occupancy query says %d\n", per_cu); per_cu = 1; }
        (void)hipGetLastError();
        grid = cus * 1;
        if (grid <= 0) grid = 256;
    }
    if (grid < 0) return;
    (void)hipMemsetAsync((char*)d_ws + WS_BAR, 0, 16384, stream);
    Args a{};
    for (int i = 0; i < 34; ++i) a.in[i] = (const float*)d_in[i];
    a.out = (float*)d_out; a.ws = (unsigned char*)d_ws;
    void* args[] = {&a};
    hipError_t e = hipLaunchCooperativeKernel((const void*)mega_fwd, dim3(grid), dim3(512), args, LDS_BYTES, stream);
    if (e != hipSuccess) fprintf(stderr, "kernel_launch: cooperative launch failed: %s (grid %d)\n", hipGetErrorString(e), grid);
}
```

```cpp
#include <hip/hip_runtime.h>
#include <hip/hip_cooperative_groups.h>
#include <cstdio>
#include <cstdint>
namespace cg = cooperative_groups;

#define LAS __attribute__((address_space(3)))
typedef unsigned short bf16_t;
typedef short bf16x8 __attribute__((ext_vector_type(8)));
typedef float f32x4 __attribute__((ext_vector_type(4)));
typedef float f32x8 __attribute__((ext_vector_type(8)));
typedef unsigned u32x4 __attribute__((ext_vector_type(4)));
typedef unsigned u32x2 __attribute__((ext_vector_type(2)));
typedef unsigned long long u64_t;
#define RS_SCALE 16777216.0f
#define RS_INV (1.0f / 16777216.0f)

constexpr int T_ALL = 32768, DM = 1024, TH = 16384, SEQ = 8192, FF = 2816, NP = 6912;
constexpr float EPS = 1e-6f;
constexpr int PC_Z = 0, PC_XBC = 512, PC_YBP = 1280, PC_Q = 1792, PC_K = 2304, PC_V = 2816, PC_G = 3328, PC_GATE = 3840;

constexpr size_t MiB = 1u << 20;
constexpr size_t WS_RS = 505 * MiB;
constexpr size_t WS_DEC = 3 * MiB / 2;
constexpr size_t WS_ROPE = 2 * MiB;
constexpr size_t WS_WGU1 = 4 * MiB, WS_WD1 = 15 * MiB, WS_WIN = 20 * MiB + MiB / 2, WS_WA = 34 * MiB, WS_WB = 35 * MiB,
                 WS_WGLU = 35 * MiB + 3 * MiB / 4, WS_WC = 36 * MiB + MiB / 2, WS_WOUT = 37 * MiB + MiB / 2, WS_WGU2 = 39 * MiB + MiB / 2,
                 WS_WD2 = 50 * MiB + MiB / 2, WS_S5S = 56 * MiB, WS_S5Y = 59 * MiB, WS_KTAB = 65 * MiB;
constexpr size_t WS_XB = 68 * MiB;
constexpr size_t WS_H = 132 * MiB;
constexpr size_t WS_P = 132 * MiB;
constexpr size_t WS_YA = 348 * MiB, WS_YB = 364 * MiB, WS_YC = 376 * MiB, WS_MIX = 392 * MiB, WS_ST = 424 * MiB,
                 WS_UG = 456 * MiB, WS_SC = 480 * MiB, WS_DT = 504 * MiB, WS_END = 508 * MiB;
constexpr int LDS_BYTES = 147456;

typedef __bf16 bf16v2_t __attribute__((ext_vector_type(2)));
typedef float f32v2_t __attribute__((ext_vector_type(2)));
__device__ __forceinline__ unsigned cvt_pk_bf16(float lo, float hi) { f32v2_t v = {lo, hi}; bf16v2_t b = __builtin_convertvector(v, bf16v2_t); return __builtin_bit_cast(unsigned, b); }
__device__ __forceinline__ unsigned f2bf(float f) { unsigned u = __builtin_bit_cast(unsigned, f); return (u + 0x7fffu + ((u >> 16) & 1u)) >> 16; }
__device__ __forceinline__ float bflo(unsigned u) { return __builtin_bit_cast(float, u << 16); }
__device__ __forceinline__ float bfhi(unsigned u) { return __builtin_bit_cast(float, u & 0xffff0000u); }
__device__ __forceinline__ float rcpf_(float x) { return __builtin_amdgcn_rcpf(x); }
__device__ __forceinline__ float sigmoidf_(float x) { return rcpf_(1.0f + __expf(-x)); }
__device__ __forceinline__ float shflx(float v, int mask, int lane) { return __builtin_bit_cast(float, __builtin_amdgcn_ds_bpermute((lane ^ mask) << 2, __builtin_bit_cast(int, v))); }
__device__ __forceinline__ void sincos_rev(float rev, float& s, float& c) { const float f = rev - floorf(rev); s = __builtin_amdgcn_sinf(f); c = __builtin_amdgcn_cosf(f); }
__device__ __forceinline__ float siluf_(float x) { return x * sigmoidf_(x); }
__device__ __forceinline__ float softplusf_(float x) { return fmaxf(x, 0.f) + __logf(1.0f + __expf(-fabsf(x))); }
__device__ __forceinline__ float gelu_tanh(float x) { const float u = 0.7978845608028654f * (x + 0.044715f * x * x * x); const float t = 1.0f - 2.0f * rcpf_(__expf(2.0f * u) + 1.0f); return 0.5f * x * (1.0f + t); }
__device__ __forceinline__ f32x8 unpack8(u32x4 v) { f32x8 o; o[0] = bflo(v.x); o[1] = bfhi(v.x); o[2] = bflo(v.y); o[3] = bfhi(v.y); o[4] = bflo(v.z); o[5] = bfhi(v.z); o[6] = bflo(v.w); o[7] = bfhi(v.w); return o; }
__device__ __forceinline__ u32x4 pack8(f32x4 a, f32x4 b) { u32x4 w; w.x = cvt_pk_bf16(a[0], a[1]); w.y = cvt_pk_bf16(a[2], a[3]); w.z = cvt_pk_bf16(b[0], b[1]); w.w = cvt_pk_bf16(b[2], b[3]); return w; }
__device__ __forceinline__ float wave_sum(float v, int lane) {
#pragma unroll
    for (int o = 1; o < 64; o <<= 1) v += shflx(v, o, lane);
    return v;
}

namespace pg8 {
constexpr int BM = 256, BK = 64, HALF = 128, HTB = HALF * BK * 2, NXCD = 8, WGM = 8;
__device__ __forceinline__ int lds_byte(int r, int c) { const int st = (r >> 4) * 2 + (c >> 5), rr = r & 15, cc = c & 31, ob = rr * 64 + cc * 2; return st * 1024 + (ob ^ (((ob >> 9) & 1) << 5)); }
__device__ __forceinline__ void stage_rc(int b, int& R, int& C) { const int st = b / 1024, sb = b % 1024, swz = sb ^ (((sb >> 9) & 1) << 5); R = (st >> 1) * 16 + swz / 64; C = (st & 1) * 32 + (swz % 64) / 2; }
__device__ __forceinline__ int perm32(int rho) { const int n = rho >> 4, i = rho & 15; return 8 * (i >> 2) + 4 * n + (i & 3); }

struct Unit { int pm, pn; };
struct Gemm { const bf16_t* A; const bf16_t* Bt; int lda, ldb, K; };

struct SchedFull {
    int nM, nN, nwg, G, c;
    __device__ void init(int nM_, int nN_, int G_, int c_) { nM = nM_; nN = nN_; nwg = nM * nN; G = G_; c = c_; }
    __device__ bool next(int i, Unit& u) const {
        const long L = (long)i * G + c; if (L >= nwg) return false;
        int wgid = (int)L; { const int q = nwg / NXCD, r = nwg % NXCD, xcd = wgid % NXCD, off = wgid / NXCD; wgid = (xcd < r ? xcd * (q + 1) : r * (q + 1) + (xcd - r) * q) + off; }
        const int nig = WGM * nN, gid = wgid / nig, fm = gid * WGM, gsz = (nM - fm) < WGM ? (nM - fm) : WGM;
        u.pm = fm + ((wgid % nig) % gsz); u.pn = (wgid % nig) / gsz; return true;
    }
};
struct SchedGrp {
    int mt, nt, ng, G, c;
    __device__ void init(int mt_, int nt_, int ng_, int G_, int c_) { mt = mt_; nt = nt_; ng = ng_; G = G_; c = c_; }
    __device__ bool next(int i, Unit& u) const {
        const int L = i * G + c; if (L >= ng * mt * nt) return false;
        const int g = L / (mt * nt), r = L % (mt * nt); u.pm = g * mt + r / nt; u.pn = g * nt + r % nt; return true;
    }
};

template <class Epi, class Sched>
__device__ __forceinline__ void gemm_phase(LAS unsigned char* lds, const Gemm g, const Sched& S, const Epi& E, int tid) {
    const int wid = __builtin_amdgcn_readfirstlane(tid >> 6), lane = tid & 63, wr = wid >> 2, wc = wid & 3, fr = lane & 15, fq = lane >> 4;
    const int K = g.K, nt = K / BK;
    unsigned voffA[2], voffB[2];
#pragma unroll
    for (int i = 0; i < 2; ++i) { int R, C; stage_rc(tid * 16 + i * 8192, R, C); const int Rb = (R & ~31) + perm32(R & 31);
        voffA[i] = (unsigned)(R * g.lda + C) * 2u; voffB[i] = (unsigned)(Rb * g.ldb + C) * 2u; }
    const size_t kstep = (size_t)(BK * 2);
    const size_t hstepA = (size_t)HALF * g.lda * 2, hstepB = (size_t)HALF * g.ldb * 2;
    const size_t tstepA = 2 * hstepA, tstepB = 2 * hstepB;
    const unsigned ldsw = (unsigned)wid * 1024u;
    const int aoff = lds_byte(wr * 64 + fr, fq * 8), boff = lds_byte(wc * 32 + fr, fq * 8);
#define PG8_SA(b, h) (((b) * 2 + (h)) * HTB)
#define PG8_SB(b, h) ((4 + (b) * 2 + (h)) * HTB)
#define PG8_STAGE(bufoff, gbase, voff) do { _Pragma("unroll") for (int _i = 0; _i < 2; ++_i) \
        __builtin_amdgcn_global_load_lds((const unsigned*)((const char*)(gbase) + (voff)[_i]), (LAS unsigned*)(lds + (bufoff) + ldsw + _i * 8192), 16, 0, 0); } while (0)
#define PG8_LDA(dst, b, h) do { _Pragma("unroll") for (int m = 0; m < 4; ++m) _Pragma("unroll") for (int k = 0; k < 2; ++k) dst[m][k] = *(const LAS bf16x8*)(lds + PG8_SA(b, h) + aoff + m * 2048 + k * 1024); } while (0)
#define PG8_LDB(dst, b, h) do { _Pragma("unroll") for (int n = 0; n < 2; ++n) _Pragma("unroll") for (int k = 0; k < 2; ++k) dst[n][k] = *(const LAS bf16x8*)(lds + PG8_SB(b, h) + boff + n * 2048 + k * 1024); } while (0)
#define PG8_MMA(ai, bj, At, Bt) do { __builtin_amdgcn_s_setprio(1); _Pragma("unroll") for (int m = 0; m < 4; ++m) _Pragma("unroll") for (int n = 0; n < 2; ++n) _Pragma("unroll") for (int k = 0; k < 2; ++k) \
        acc[ai][bj][m][n] = __builtin_amdgcn_mfma_f32_16x16x32_bf16(Bt[n][k], At[m][k], acc[ai][bj][m][n], 0, 0, 0); __builtin_amdgcn_s_setprio(0); } while (0)
#define PG8_WAIT_V(n) asm volatile("s_waitcnt vmcnt(" #n ")" ::: "memory")
#define PG8_WAIT_L(n) asm volatile("s_waitcnt lgkmcnt(" #n ")" ::: "memory")
#define PG8_BAR __builtin_amdgcn_s_barrier()
#define PG8_SCHED __builtin_amdgcn_sched_barrier(0)
    Unit cur, nxt; int ui = 0;
    if (!S.next(0, cur)) return;
    f32x4 acc[2][2][4][2];
#pragma unroll
    for (int a = 0; a < 2; ++a)
#pragma unroll
        for (int b = 0; b < 2; ++b)
#pragma unroll
            for (int m = 0; m < 4; ++m)
#pragma unroll
                for (int n = 0; n < 2; ++n) acc[a][b][m][n] = (f32x4){0.f, 0.f, 0.f, 0.f};
    bf16x8 At[4][2], B0[2][2], B1[2][2];
    const char* cA = (const char*)g.A + (size_t)cur.pm * tstepA; const char* cB = (const char*)g.Bt + (size_t)cur.pn * tstepB;
    PG8_STAGE(PG8_SB(0, 0), cB, voffB); PG8_STAGE(PG8_SB(0, 1), cB + hstepB, voffB); PG8_STAGE(PG8_SA(0, 0), cA, voffA); PG8_STAGE(PG8_SA(0, 1), cA + hstepA, voffA);
    if (wr == 1) PG8_BAR;
    PG8_WAIT_V(2); PG8_BAR;
    PG8_STAGE(PG8_SB(1, 0), cB + kstep, voffB); PG8_STAGE(PG8_SA(1, 0), cA + kstep, voffA); PG8_STAGE(PG8_SB(1, 1), cB + hstepB + kstep, voffB);
    PG8_WAIT_V(6); PG8_BAR;
    for (;;) {
        const bool has_next = S.next(ui + 1, nxt);
        const char* nA = has_next ? (const char*)g.A + (size_t)nxt.pm * tstepA : cA; const char* nB = has_next ? (const char*)g.Bt + (size_t)nxt.pn * tstepB : cB;
        for (int t = 0; t < nt; t += 2) {
            const bool last = (t == nt - 2);
            const char* a1 = cA + (size_t)(t + 1) * kstep;
            const char* a2 = last ? nA : cA + (size_t)(t + 2) * kstep; const char* b2 = last ? nB : cB + (size_t)(t + 2) * kstep;
            const char* a3 = a2 + kstep; const char* b3 = b2 + kstep;
            PG8_LDB(B0, 0, 0); PG8_LDB(B1, 0, 1); PG8_SCHED; PG8_LDA(At, 0, 0); PG8_STAGE(PG8_SA(1, 1), a1 + hstepA, voffA);
            PG8_WAIT_V(8); PG8_WAIT_L(0); PG8_BAR; PG8_MMA(0, 0, At, B0); PG8_MMA(0, 1, At, B1); PG8_BAR; PG8_SCHED;
            PG8_LDA(At, 0, 1); PG8_STAGE(PG8_SB(0, 0), b2, voffB); PG8_STAGE(PG8_SB(0, 1), b2 + hstepB, voffB); PG8_STAGE(PG8_SA(0, 0), a2, voffA);
            PG8_WAIT_V(8); PG8_WAIT_L(0); PG8_BAR; PG8_MMA(1, 0, At, B0); PG8_MMA(1, 1, At, B1); PG8_BAR; PG8_SCHED;
            PG8_LDB(B0, 1, 0); PG8_LDB(B1, 1, 1); PG8_SCHED; PG8_LDA(At, 1, 0); PG8_STAGE(PG8_SA(0, 1), a2 + hstepA, voffA);
            PG8_WAIT_V(8); PG8_WAIT_L(0); PG8_BAR; PG8_MMA(0, 0, At, B0); PG8_MMA(0, 1, At, B1); PG8_BAR; PG8_SCHED;
            PG8_LDA(At, 1, 1); PG8_STAGE(PG8_SB(1, 0), b3, voffB); PG8_STAGE(PG8_SB(1, 1), b3 + hstepB, voffB); PG8_STAGE(PG8_SA(1, 0), a3, voffA);
            PG8_WAIT_V(8); PG8_WAIT_L(0); PG8_BAR; PG8_MMA(1, 0, At, B0); PG8_MMA(1, 1, At, B1); PG8_BAR; PG8_SCHED;
        }
        if (wr == 0) PG8_BAR;
        { int z_ = 0; asm volatile("" : "+s"(z_)); const int l2 = __builtin_amdgcn_mbcnt_hi(~0u, __builtin_amdgcn_mbcnt_lo(~0u, z_));
          E(acc, cur, wr, wc, l2 & 15, l2 >> 4); }
        if (!has_next) break;
#pragma unroll
        for (int a = 0; a < 2; ++a)
#pragma unroll
            for (int b = 0; b < 2; ++b)
#pragma unroll
                for (int m = 0; m < 4; ++m)
#pragma unroll
                    for (int n = 0; n < 2; ++n) acc[a][b][m][n] = (f32x4){0.f, 0.f, 0.f, 0.f};
        cur = nxt; cA = nA; cB = nB; ++ui;
        if (wr == 1) PG8_BAR;
    }
    PG8_WAIT_V(0);
    PG8_BAR;
#undef PG8_SA
#undef PG8_SB
#undef PG8_STAGE
#undef PG8_LDA
#undef PG8_LDB
#undef PG8_MMA
#undef PG8_WAIT_V
#undef PG8_WAIT_L
#undef PG8_BAR
#undef PG8_SCHED
}
}
using pg8::Unit;
typedef f32x4 Acc[2][2][4][2];

struct Args { const float* in[34]; float* out; unsigned char* ws; };
typedef const __attribute__((address_space(4))) Args* KArgP;
#define KARGS() KArgP ap = (KArgP)__builtin_amdgcn_kernarg_segment_ptr(); asm volatile("" : "+s"(ap)); unsigned char* ws = ap->ws; (void)ws
#define TID_LOCAL() int z_ = 0; asm volatile("" : "+s"(z_)); const int lane = __builtin_amdgcn_mbcnt_hi(~0u, __builtin_amdgcn_mbcnt_lo(~0u, z_)); int wave = wave0; asm volatile("" : "+s"(wave)); const int tid = wave * 64 + lane; const int gw = bid * 8 + wave, gt = bid * 512 + tid; (void)lane; (void)wave; (void)gw; (void)gt
#define WSP(type, off) ((type*)(ws + (off)))
#define PHASE() KARGS(); int bid = blockIdx.x, G = gridDim.x; asm volatile("" : "+s"(bid), "+s"(G)); LAS unsigned char* lds = lds0; asm volatile("" : "+s"(lds)); const int NGW = G * 8, NGT = G * 512; (void)NGW; (void)NGT
struct EpiGU {
    int rs_in;
    __device__ __forceinline__ void operator()(const Acc& acc, const Unit& u, int wr, int wc, int fr, int fq) const {
        KARGS(); bf16_t* H = WSP(bf16_t, WS_H); const u64_t* rs = WSP(u64_t, WS_RS) + (size_t)rs_in * T_ALL;
        const int rowb = u.pm * 256 + wr * 64 + fr; const int hc = u.pn * 128 + wc * 32 + fq * 8;
#pragma unroll
        for (int ai = 0; ai < 2; ++ai)
#pragma unroll
            for (int m = 0; m < 4; ++m) { const int row = rowb + ai * 128 + m * 16; const float rstd = rsqrtf((float)rs[row] * (RS_INV / DM) + EPS);
                f32x4 h0, h1;
#pragma unroll
                for (int i = 0; i < 4; ++i) { h0[i] = siluf_(acc[ai][0][m][0][i] * rstd) * (acc[ai][1][m][0][i] * rstd); h1[i] = siluf_(acc[ai][0][m][1][i] * rstd) * (acc[ai][1][m][1][i] * rstd); }
                *(u32x4*)(H + (size_t)row * FF + hc) = pack8(h0, h1); }
    }
};
struct EpiRes {
    int base_in; int row0; int rs_o; float coef;
    __device__ __forceinline__ void operator()(const Acc& acc, const Unit& u, int wr, int wc, int fr, int fq) const {
        KARGS(); (void)base_in;
        bf16_t* XB = WSP(bf16_t, WS_XB) + (size_t)row0 * DM; u64_t* rs_out = WSP(u64_t, WS_RS) + (size_t)rs_o * T_ALL + row0;
        const int rowb = u.pm * 256 + wr * 64 + fr; const int cl = u.pn * 256 + wc * 32 + 8 * fq;
#pragma unroll
        for (int ai = 0; ai < 2; ++ai)
#pragma unroll
            for (int m = 0; m < 4; ++m) { const int row = rowb + ai * 128 + m * 16; float ss = 0.f;
#pragma unroll
                for (int bj = 0; bj < 2; ++bj) { const size_t off = (size_t)row * DM + cl + bj * 128;
                    const f32x8 bv = unpack8(*(const u32x4*)(XB + off));
                    f32x4 x0, x1;
#pragma unroll
                    for (int i = 0; i < 4; ++i) { x0[i] = bv[i] + coef * acc[ai][bj][m][0][i]; x1[i] = bv[4 + i] + coef * acc[ai][bj][m][1][i]; }
                    *(u32x4*)(XB + off) = pack8(x0, x1);
                    ss += (x0[0] * x0[0] + x0[1] * x0[1]) + (x0[2] * x0[2] + x0[3] * x0[3]) + (x1[0] * x1[0] + x1[1] * x1[1]) + (x1[2] * x1[2] + x1[3] * x1[3]); }
                { const int ln = fq * 16 + fr; ss += shflx(ss, 16, ln); ss += shflx(ss, 32, ln); }
                if (fq == 0) atomicAdd(rs_out + row, (u64_t)(ss * RS_SCALE)); }
    }
};
struct EpiInproj {
    int row0; int rs_b; int layer;
    __device__ __forceinline__ void operator()(const Acc& acc, const Unit& u, int wr, int wc, int fr, int fq) const {
        KARGS(); bf16_t* P = WSP(bf16_t, WS_P); bf16_t* UG = WSP(bf16_t, WS_UG); float* DT = WSP(float, WS_DT); const u64_t* rs = WSP(u64_t, WS_RS) + (size_t)rs_b * T_ALL + row0;
        const float* ropec = WSP(float, WS_ROPE); const float* ropes = ropec + SEQ * 32; const float* bgate = ap->in[7] + layer * 3072;
        const int pn = u.pn; const int rowb = u.pm * 256 + wr * 64 + fr; const int cl = wc * 32 + 8 * fq;
#pragma unroll
        for (int ai = 0; ai < 2; ++ai)
#pragma unroll
            for (int m = 0; m < 4; ++m) { const int row = rowb + ai * 128 + m * 16; const float rstd = rsqrtf((float)rs[row] * (RS_INV / DM) + EPS);
#pragma unroll
                for (int bj = 0; bj < 2; ++bj) {
                    f32x4 v0 = acc[ai][bj][m][0] * rstd, v1 = acc[ai][bj][m][1] * rstd; const int col = pn * 256 + bj * 128 + cl;
                    if (pn <= 4 || (pn >= 11 && pn <= 14)) { *(u32x4*)(P + (size_t)row * NP + col) = pack8(v0, v1); }
                    else if (pn <= 6) { const int j0 = (pn - 5) * 256 + bj * 128 + cl;
                        if (j0 < 384) { const int g = j0 >> 4, c = j0 & 15; *(u32x4*)(UG + ((size_t)(g * 1024 + (row >> 4)) * 512) + (row & 15) * 16 + c) = pack8(v0, v1); }
                        else if (j0 < 400) { *(f32x4*)(DT + (size_t)row * 16 + (j0 - 384)) = v0; *(f32x4*)(DT + (size_t)row * 16 + (j0 - 384) + 4) = v1; } }
                    else if (pn <= 10) { const int gi = ((bj * 128 + cl) & 63) >> 3; const int pos = row & (SEQ - 1);
                        const f32x4 c = *(const f32x4*)(ropec + pos * 32 + gi * 4), s = *(const f32x4*)(ropes + pos * 32 + gi * 4);
                        f32x4 o0 = v0 * c - v1 * s, o1 = v0 * s + v1 * c; if (pn >= 9) { o0 = o0 * 0.125f; o1 = o1 * 0.125f; }
                        *(u32x4*)(P + (size_t)row * NP + col) = pack8(o0, o1); }
                    else { const int gidx = (pn - 15) * 256 + bj * 128 + cl; f32x4 b0, b1;
#pragma unroll
                        for (int i_ = 0; i_ < 4; ++i_) { b0[i_] = bgate[gidx + i_]; b1[i_] = bgate[gidx + 4 + i_]; }
#pragma unroll
                        for (int i = 0; i < 4; ++i) { v0[i] = sigmoidf_(v0[i] + b0[i]); v1[i] = sigmoidf_(v1[i] + b1[i]); }
                        *(u32x4*)(P + (size_t)row * NP + col) = pack8(v0, v1); } } }
    }
};
struct EpiS5S {
    int dummy;
    __device__ __forceinline__ void operator()(const Acc& acc, const Unit& u, int wr, int wc, int fr, int fq) const {
        KARGS(); float* SC = WSP(float, WS_SC);
        const int rowb = u.pm * 256 + wr * 64 + fr; const int cl = wc * 32 + 8 * fq;
#pragma unroll
        for (int ai = 0; ai < 2; ++ai)
#pragma unroll
            for (int m = 0; m < 4; ++m) { const int row = rowb + ai * 128 + m * 16;
#pragma unroll
                for (int bj = 0; bj < 2; ++bj) { float* o = SC + (size_t)row * 256 + bj * 128 + cl; *(f32x4*)o = acc[ai][bj][m][0]; *(f32x4*)(o + 4) = acc[ai][bj][m][1]; } }
    }
};
struct EpiS5Y {
    int dummy;
    __device__ __forceinline__ void operator()(const Acc& acc, const Unit& u, int wr, int wc, int fr, int fq) const {
        KARGS(); bf16_t* P = WSP(bf16_t, WS_P);
        const int rowb = u.pm * 256 + wr * 64 + fr; const int cl = wc * 32 + 8 * fq;
#pragma unroll
        for (int ai = 0; ai < 2; ++ai)
#pragma unroll
            for (int m = 0; m < 4; ++m) { const int R = rowb + ai * 128 + m * 16; const int g = R >> 10, chunk = R & 1023;
#pragma unroll
                for (int bj = 0; bj < 2; ++bj) { const int c0 = bj * 128 + cl; const int t = c0 >> 4, c = c0 & 15; f32x4 v0 = acc[ai][bj][m][0], v1 = acc[ai][bj][m][1];
#pragma unroll
                    for (int i = 0; i < 4; ++i) { v0[i] = gelu_tanh(v0[i]); v1[i] = gelu_tanh(v1[i]); }
                    *(u32x4*)(P + (size_t)(chunk * 16 + t) * NP + PC_YBP + g * 16 + c) = pack8(v0, v1); } }
    }
};
struct EpiGLU {
    int dummy;
    __device__ __forceinline__ void operator()(const Acc& acc, const Unit& u, int wr, int wc, int fr, int fq) const {
        KARGS(); bf16_t* YB = WSP(bf16_t, WS_YB);
        const int rowb = u.pm * 256 + wr * 64 + fr; const int hc = u.pn * 128 + wc * 32 + fq * 8;
#pragma unroll
        for (int ai = 0; ai < 2; ++ai)
#pragma unroll
            for (int m = 0; m < 4; ++m) { const int row = rowb + ai * 128 + m * 16; f32x4 h0, h1;
#pragma unroll
                for (int i = 0; i < 4; ++i) { h0[i] = acc[ai][0][m][0][i] * sigmoidf_(acc[ai][1][m][0][i]); h1[i] = acc[ai][0][m][1][i] * sigmoidf_(acc[ai][1][m][1][i]); }
                *(u32x4*)(YB + (size_t)row * 384 + hc) = pack8(h0, h1); }
    }
};
struct EpiBr {
    int gcol; int rss_row; int first;
    __device__ __forceinline__ void operator()(const Acc& acc, const Unit& u, int wr, int wc, int fr, int fq) const {
        KARGS(); bf16_t* MIX = WSP(bf16_t, WS_MIX); const bf16_t* P = WSP(bf16_t, WS_P); const u64_t* rss = (rss_row >= 0) ? (WSP(u64_t, WS_RS) + rss_row) : nullptr;
        const int rowb = u.pm * 256 + wr * 64 + fr; const int cl = u.pn * 256 + wc * 32 + 8 * fq;
#pragma unroll
        for (int ai = 0; ai < 2; ++ai)
#pragma unroll
            for (int m = 0; m < 4; ++m) { const int row = rowb + ai * 128 + m * 16; const float sc = rss ? rsqrtf((float)rss[row] * (RS_INV / 512.0f) + EPS) : 1.0f;
#pragma unroll
                for (int bj = 0; bj < 2; ++bj) { const int col = cl + bj * 128;
                    const f32x8 gt = unpack8(*(const u32x4*)(P + (size_t)row * NP + gcol + col));
                    f32x4 a0 = acc[ai][bj][m][0] * sc, a1 = acc[ai][bj][m][1] * sc;
#pragma unroll
                    for (int i = 0; i < 4; ++i) { a0[i] *= gt[i]; a1[i] *= gt[4 + i]; }
                    if (!first) { const f32x8 pv = unpack8(*(const u32x4*)(MIX + (size_t)row * DM + col));
#pragma unroll
                        for (int i = 0; i < 4; ++i) { a0[i] += pv[i]; a1[i] += pv[4 + i]; } }
                    *(u32x4*)(MIX + (size_t)row * DM + col) = pack8(a0, a1); } }
    }
};

struct TrSrc { int ld; int N; int mode; };
__device__ __forceinline__ const float* tr_col(const TrSrc& s, const float* W, const float* W2, int n) {
    if (s.mode == 0) return W + n;
    if (s.mode == 1) { const int j = (n >> 8) * 128 + (n & 127); const long d = ((n >> 7) & 1) ? (long)(W2 - W) : 0l; return W + d + j; }
    int src;
    if (n < 1280) src = n;
    else if (n < 1792) { const int j = n - 1280; if (j < 384) src = 1296 + j; else if (j < 400) src = 1280 + (j - 384); else return nullptr; }
    else if (n < 2816) { int hc = n - 1792; const int isk = hc >= 512; hc &= 511; const int hh = hc >> 6, c = hc & 63; const int d = 4 * (c >> 3) + (c & 3) + 32 * ((c >> 2) & 1); src = (isk ? 2192 : 1680) + hh * 64 + d; }
    else if (n < 3328) src = 2704 + (n - 2816);
    else if (n < 3840) src = 3216 + (n - 3328);
    else src = 3728 + (n - 3840);
    return W + src;
}
__device__ __forceinline__ void tr_item(const float* W, const float* W2, const float* gain, const TrSrc s, int K, bf16_t* WT, LAS float* scr, int item, int lane) {
    const int nblk = s.N / 32, kb = item / nblk, nb = item % nblk, k0 = 64 * kb, n0 = 32 * nb;
    const float* col = tr_col(s, W, W2, n0 + (lane & 31));
    float tv[32];
#pragma unroll
    for (int i = 0; i < 32; ++i) { const int kk = 2 * i + (lane >> 5); tv[i] = col ? col[(size_t)(k0 + kk) * s.ld] : 0.f; }
#pragma unroll
    for (int i = 0; i < 32; ++i) { const int kk = 2 * i + (lane >> 5); float v = tv[i]; if (gain) v *= gain[k0 + kk]; scr[kk * 33 + (lane & 31)] = v; }
    asm volatile("s_waitcnt lgkmcnt(0)" ::: "memory");
    const int c = lane & 7;
#pragma unroll
    for (int j = 0; j < 4; ++j) { const int n = (lane >> 3) + 8 * j; const LAS float* sp = scr + (8 * c) * 33 + n;
        u32x4 o; o.x = cvt_pk_bf16(sp[0 * 33], sp[1 * 33]); o.y = cvt_pk_bf16(sp[2 * 33], sp[3 * 33]); o.z = cvt_pk_bf16(sp[4 * 33], sp[5 * 33]); o.w = cvt_pk_bf16(sp[6 * 33], sp[7 * 33]);
        *(u32x4*)(WT + (size_t)(n0 + n) * K + k0 + 8 * c) = o; }
    asm volatile("s_waitcnt lgkmcnt(0)" ::: "memory");
}

struct S5P { const float *lre, *lim, *lstep, *bre, *bim, *cre, *cim, *d; };
__device__ __forceinline__ void s5_lam(const S5P& p, int dir, int g, int pp, float& lre, float& lim, float& step) {
    lre = fminf(p.lre[(dir * 24 + g) * 64 + pp], -1e-4f); lim = p.lim[(dir * 24 + g) * 64 + pp]; step = __expf(p.lstep[dir * 24 + g]);
}
__device__ __forceinline__ void cpowf_(float lre, float lim, float step, float tau, float& re, float& im) {
    const float mag = __expf(lre * step * tau); const float ang = lim * step * tau; float s, c; sincos_rev(ang * 0.15915494309189535f, s, c); re = mag * c; im = mag * s;
}
__device__ __forceinline__ void s5_coef(float lre, float lim, float step, float& cr, float& ci) {
    float lbr, lbi; cpowf_(lre, lim, step, 1.0f, lbr, lbi); const float nr = lbr - 1.0f, den = lre * lre + lim * lim;
    const float rd = rcpf_(den); cr = (nr * lre + lbi * lim) * rd; ci = (lbi * lre - nr * lim) * rd;
}

struct LaCtx { const bf16_t* P; const float* DT; bf16_t* ST; float* DEC; bf16_t* YA; bf16_t* YC; u64_t* rss; const float* conv_w; const float* conv_b; const float* dt_bias; const float* a_log; const float* dskip; };
constexpr int LA_F32 = 107520;
__device__ __forceinline__ f32x8 la_fetch8(LAS unsigned char* lds, const LaCtx& c, int m, int kind, int h, int row, int c8) {
    if (m == 1) { const int col = (kind == 0 ? PC_V : (kind == 1 ? PC_K : PC_Q)) + h * 64 + c8; return unpack8(*(const u32x4*)(c.P + (size_t)row * NP + col)); }
    const int ch = (kind == 0) ? (h * 64 + c8) : ((kind == 1 ? 512 : 640) + (h >> 2) * 64 + c8);
    const int pos = row & (SEQ - 1);
    const LAS float* cwl = (const LAS float*)(lds + LA_F32 + 4096) + ch;
    f32x8 a; { const f32x4 t0 = *(const LAS f32x4*)(cwl + 3840), t1 = *(const LAS f32x4*)(cwl + 3844); a[0] = t0[0]; a[1] = t0[1]; a[2] = t0[2]; a[3] = t0[3]; a[4] = t1[0]; a[5] = t1[1]; a[6] = t1[2]; a[7] = t1[3]; }
#pragma unroll
    for (int j = 0; j < 5; ++j) { const int pp = pos + j - 2;
        if ((unsigned)pp < (unsigned)SEQ) { const f32x8 v = unpack8(*(const u32x4*)(c.P + (size_t)(row + j - 2) * NP + PC_XBC + ch));
            const f32x4 w0 = *(const LAS f32x4*)(cwl + j * 768), w1 = *(const LAS f32x4*)(cwl + j * 768 + 4);
#pragma unroll
            for (int e = 0; e < 4; ++e) { a[e] += w0[e] * v[e]; a[4 + e] += w1[e] * v[4 + e]; } } }
#pragma unroll
    for (int e = 0; e < 8; ++e) a[e] = siluf_(a[e]);
    return a;
}
__device__ __forceinline__ void la_stage_conv_all(LAS unsigned char* lds, const LaCtx& c, int tid) {
    LAS float* cwl = (LAS float*)(lds + LA_F32 + 4096);
    for (int i = tid; i < 4608; i += 512) cwl[i] = (i < 3840) ? c.conv_w[i] : c.conv_b[i - 3840];
    __syncthreads();
}
__device__ __forceinline__ void la_cs(LAS unsigned char* lds, const LaCtx& c, int m, int h, int rowbase, int wave, int lane) {
    LAS float* cs0 = (LAS float*)(lds + LA_F32); LAS float* ce1 = cs0 + 128; LAS float* dtf = ce1 + 132; LAS float* dtb = dtf + 128; LAS float* dg = dtb + 128;
    if (wave >= 2) return;
    const int t0 = 2 * lane; float d0a = 1.f, d0b = 1.f, d1a = 1.f, d1b = 1.f, x0, x1, dga = 1.f, dgb = 1.f;
    if (m == 0) {
        d0a = softplusf_(c.DT[(size_t)(rowbase + t0) * 16 + h] + c.dt_bias[h]); d0b = softplusf_(c.DT[(size_t)(rowbase + t0 + 1) * 16 + h] + c.dt_bias[h]);
        d1a = softplusf_(c.DT[(size_t)(rowbase + t0) * 16 + 8 + h] + c.dt_bias[8 + h]); d1b = softplusf_(c.DT[(size_t)(rowbase + t0 + 1) * 16 + 8 + h] + c.dt_bias[8 + h]);
        const float A = -__expf(c.a_log[wave * 8 + h]);
        x0 = (wave == 0 ? d0a : d1a) * A; x1 = (wave == 0 ? d0b : d1b) * A;
        dga = d0a + d1a; dgb = d0b + d1b;
    } else { const float e_ = __builtin_amdgcn_ldexpf(1.0f, -5 - h); const float lg = -(e_ + e_ * e_ * (0.5f + e_ * (0.33333334f + 0.25f * e_))); x0 = lg; x1 = lg; }
    const float pair = x0 + x1; float inc = pair;
#pragma unroll
    for (int off = 1; off < 64; off <<= 1) { const float v = __builtin_bit_cast(float, __builtin_amdgcn_ds_bpermute((lane - off) << 2, __builtin_bit_cast(int, inc))); if (lane >= off) inc += v; }
    const float exc = inc - pair;
    if (wave == 0) { cs0[t0] = exc + x0; cs0[t0 + 1] = inc; dtf[t0] = d0a; dtf[t0 + 1] = d0b; dg[t0] = dga; dg[t0 + 1] = dgb; }
    else { ce1[t0] = exc; ce1[t0 + 1] = exc + x0; if (lane == 63) ce1[128] = inc; dtb[t0] = d1a; dtb[t0 + 1] = d1b; }
}
#define MFMA16(a, b, c) __builtin_amdgcn_mfma_f32_16x16x32_bf16(a, b, c, 0, 0, 0)
__device__ __forceinline__ int tsw(int row, int s) { return (((s >> 3) ^ ((row >> 3) & 7)) << 3) | (s & 7); }
__device__ __forceinline__ void la_unit_A(LAS unsigned char* lds, const LaCtx c, int m, int bb, int ci, int h, int tid) {
    const int wave = __builtin_amdgcn_readfirstlane(tid >> 6), lane = tid & 63;
    LAS float* cs0 = (LAS float*)(lds + LA_F32); LAS float* ce1 = cs0 + 128; LAS float* dtf = ce1 + 132; LAS float* dtb = dtf + 128;
    const int rowbase = bb * SEQ + ci * 128;
    la_cs(lds, c, m, h, rowbase, wave, lane);
    __syncthreads();
    const float csl = cs0[127];
#pragma unroll
    for (int it = 0; it < 2; ++it) { const int idx = tid + it * 512; const int s = idx >> 3, c8 = (idx & 7) * 8;
        const f32x8 x = la_fetch8(lds, c, m, 0, h, rowbase + s, c8), b = la_fetch8(lds, c, m, 1, h, rowbase + s, c8);
        const float wf = __expf(csl - cs0[s]) * dtf[s], wb = __expf(ce1[s]) * dtb[s];
        const int sw = tsw(c8, s);
        LAS bf16_t* xt = (LAS bf16_t*)(lds) + c8 * 136 + sw; LAS bf16_t* bf = (LAS bf16_t*)(lds + 17408) + c8 * 136 + sw; LAS bf16_t* bk = (LAS bf16_t*)(lds + 34816) + c8 * 136 + sw;
#pragma unroll
        for (int e = 0; e < 8; ++e) { xt[e * 136] = (bf16_t)f2bf(x[e]); bf[e * 136] = (bf16_t)f2bf(b[e] * wf); bk[e * 136] = (bf16_t)f2bf(b[e] * wb); } }
    if (tid < 2) c.DEC[((((m * 2 + bb) * 8 + h) * 2 + tid) * 64) + ci] = (tid == 0) ? __expf(csl) : __expf(ce1[128]);
    __syncthreads();
    const int dir = wave >> 2, nb = wave & 3, q = lane >> 4, r16 = lane & 15;
    LAS unsigned char* Bt = lds + 17408 + dir * 17408;
    bf16x8 af[4];
#pragma unroll
    for (int ks = 0; ks < 4; ++ks) af[ks] = *(const LAS bf16x8*)(Bt + ((16 * nb + r16) * 136 + tsw(16 * nb + r16, 32 * ks + 8 * q)) * 2);
    bf16_t* stb = c.ST + ((size_t)((((m * 2 + bb) * 8 + h) * 2 + dir) * 64 + ci)) * 4096;
#pragma unroll
    for (int pb = 0; pb < 4; ++pb) { f32x4 acc = (f32x4){0.f, 0.f, 0.f, 0.f};
#pragma unroll
        for (int ks = 0; ks < 4; ++ks) { const bf16x8 bfr = *(const LAS bf16x8*)(lds + ((16 * pb + r16) * 136 + tsw(16 * pb + r16, 32 * ks + 8 * q)) * 2); acc = MFMA16(af[ks], bfr, acc); }
        u32x2 w; w.x = cvt_pk_bf16(acc[0], acc[1]); w.y = cvt_pk_bf16(acc[2], acc[3]);
        *(u32x2*)(stb + (16 * pb + r16) * 64 + 16 * nb + 4 * q) = w; }
    __syncthreads();
}
__device__ __forceinline__ void la_unit_C(LAS unsigned char* lds, const LaCtx c, int m, int bb, int ci, int h, int tid, int grow0) {
    const int wave = __builtin_amdgcn_readfirstlane(tid >> 6), lane = tid & 63;
    LAS float* cs0 = (LAS float*)(lds + LA_F32); LAS float* ce1 = cs0 + 128; LAS float* dtf = ce1 + 132; LAS float* dtb = dtf + 128; LAS float* dg = dtb + 128;
    constexpr int O_CQ = 0, O_BK = 18432, O_XT = 36864, O_P = 54272, O_SF = 89088, O_SB = 98304;
    const int rowbase = bb * SEQ + ci * 128;
    la_cs(lds, c, m, h, rowbase, wave, lane);
#pragma unroll
    for (int it = 0; it < 2; ++it) { const int idx = tid + it * 512; const int s = idx >> 3, c8 = (idx & 7) * 8;
        const f32x8 x = la_fetch8(lds, c, m, 0, h, rowbase + s, c8), b = la_fetch8(lds, c, m, 1, h, rowbase + s, c8), qv = la_fetch8(lds, c, m, 2, h, rowbase + s, c8);
        u32x4 wq, wb;
        wq.x = cvt_pk_bf16(qv[0], qv[1]); wq.y = cvt_pk_bf16(qv[2], qv[3]); wq.z = cvt_pk_bf16(qv[4], qv[5]); wq.w = cvt_pk_bf16(qv[6], qv[7]);
        wb.x = cvt_pk_bf16(b[0], b[1]); wb.y = cvt_pk_bf16(b[2], b[3]); wb.z = cvt_pk_bf16(b[4], b[5]); wb.w = cvt_pk_bf16(b[6], b[7]);
        *(LAS u32x4*)(lds + O_CQ + (s * 72 + c8) * 2) = wq; *(LAS u32x4*)(lds + O_BK + (s * 72 + c8) * 2) = wb;
        LAS bf16_t* xt = (LAS bf16_t*)(lds + O_XT) + c8 * 136 + tsw(c8, s);
#pragma unroll
        for (int e = 0; e < 8; ++e) xt[e * 136] = (bf16_t)f2bf(x[e]); }
    { const bf16_t* sf = c.ST + ((size_t)((((m * 2 + bb) * 8 + h) * 2 + 0) * 64 + ci)) * 4096 + tid * 8; const bf16_t* sb = sf + (size_t)64 * 4096;
      const int p = tid >> 3, n8 = (tid & 7) * 8;
      *(LAS u32x4*)(lds + O_SF + (p * 72 + n8) * 2) = *(const u32x4*)sf; *(LAS u32x4*)(lds + O_SB + (p * 72 + n8) * 2) = *(const u32x4*)sb; }
    __syncthreads();
    const int q = lane >> 4, r16 = lane & 15; const int t = 16 * wave + r16;
    u32x2 zg[4];
#pragma unroll
    for (int pb = 0; pb < 4; ++pb) zg[pb] = *(const u32x2*)(c.P + (size_t)(rowbase + t) * NP + (m == 0 ? PC_Z : PC_G) + h * 64 + 16 * pb + 4 * q);
    bf16x8 bq[2];
#pragma unroll
    for (int ks = 0; ks < 2; ++ks) bq[ks] = *(const LAS bf16x8*)(lds + O_CQ + (t * 72 + 32 * ks + 8 * q) * 2);
    const float cs0_t = cs0[t], ce1_t = ce1[t], dg_t = dg[t];
#pragma unroll
    for (int sb = 0; sb < 8; ++sb) { f32x4 acc = (f32x4){0.f, 0.f, 0.f, 0.f};
#pragma unroll
        for (int ks = 0; ks < 2; ++ks) { const bf16x8 a = *(const LAS bf16x8*)(lds + O_BK + ((16 * sb + r16) * 72 + 32 * ks + 8 * q) * 2); acc = MFMA16(a, bq[ks], acc); }
        const int s0 = 16 * sb + 4 * q;
        const f32x4 c0 = *(const LAS f32x4*)(cs0 + s0), e1 = *(const LAS f32x4*)(ce1 + s0), df = *(const LAS f32x4*)(dtf + s0), db = *(const LAS f32x4*)(dtb + s0);
        float pv[4];
#pragma unroll
        for (int r = 0; r < 4; ++r) { const int s = s0 + r; const float arg = (s < t) ? (cs0_t - c0[r]) : (e1[r] - ce1_t);
            float w = __expf(arg) * ((s < t) ? df[r] : db[r]); if (s == t) w = dg_t; pv[r] = acc[r] * w; }
        u32x2 w2; w2.x = cvt_pk_bf16(pv[0], pv[1]); w2.y = cvt_pk_bf16(pv[2], pv[3]);
        *(LAS u32x2*)(lds + O_P + (t * 136 + s0) * 2) = w2; }
    __syncthreads();
    f32x4 aY[4], aF[4], aB[4];
#pragma unroll
    for (int pb = 0; pb < 4; ++pb) { aY[pb] = (f32x4){0.f, 0.f, 0.f, 0.f}; aF[pb] = aY[pb]; aB[pb] = aY[pb]; }
#pragma unroll
    for (int ks = 0; ks < 4; ++ks) { const bf16x8 bp = *(const LAS bf16x8*)(lds + O_P + (t * 136 + 32 * ks + 8 * q) * 2);
#pragma unroll
        for (int pb = 0; pb < 4; ++pb) { const bf16x8 a = *(const LAS bf16x8*)(lds + O_XT + ((16 * pb + r16) * 136 + tsw(16 * pb + r16, 32 * ks + 8 * q)) * 2); aY[pb] = MFMA16(a, bp, aY[pb]); } }
#pragma unroll
    for (int ks = 0; ks < 2; ++ks)
#pragma unroll
        for (int pb = 0; pb < 4; ++pb) { const bf16x8 a = *(const LAS bf16x8*)(lds + O_SF + ((16 * pb + r16) * 72 + 32 * ks + 8 * q) * 2); aF[pb] = MFMA16(a, bq[ks], aF[pb]);
            const bf16x8 a2 = *(const LAS bf16x8*)(lds + O_SB + ((16 * pb + r16) * 72 + 32 * ks + 8 * q) * 2); aB[pb] = MFMA16(a2, bq[ks], aB[pb]); }
    const float rf = __expf(cs0_t), rb = __expf(ce1[128] - ce1_t);
    const int row = rowbase + t;
    float ss = 0.f; f32x4 y[4];
#pragma unroll
    for (int pb = 0; pb < 4; ++pb) { y[pb] = aY[pb] + rf * aF[pb] + rb * aB[pb]; }
    if (m == 0) {
        const float dsk = c.dskip[h];
#pragma unroll
        for (int pb = 0; pb < 4; ++pb)
#pragma unroll
            for (int r = 0; r < 4; ++r) { const unsigned xv = *((const LAS bf16_t*)(lds + O_XT) + (16 * pb + 4 * q + r) * 136 + tsw(16 * pb + 4 * q + r, t)); y[pb][r] += dsk * __builtin_bit_cast(float, xv << 16); }
#pragma unroll
        for (int pb = 0; pb < 4; ++pb) { const int col = h * 64 + 16 * pb + 4 * q; const u32x2 zz = zg[pb];
            f32x4 o; o[0] = y[pb][0] * siluf_(bflo(zz.x)); o[1] = y[pb][1] * siluf_(bfhi(zz.x)); o[2] = y[pb][2] * siluf_(bflo(zz.y)); o[3] = y[pb][3] * siluf_(bfhi(zz.y));
            ss += (o[0] * o[0] + o[1] * o[1]) + (o[2] * o[2] + o[3] * o[3]);
            u32x2 w; w.x = cvt_pk_bf16(o[0], o[1]); w.y = cvt_pk_bf16(o[2], o[3]); *(u32x2*)(c.YA + (size_t)row * 512 + col) = w; }
        ss += shflx(ss, 16, lane); ss += shflx(ss, 32, lane);
        if (q == 0) atomicAdd(c.rss + grow0 + row, (u64_t)(ss * RS_SCALE));
    } else {
#pragma unroll
        for (int pb = 0; pb < 4; ++pb) ss += (y[pb][0] * y[pb][0] + y[pb][1] * y[pb][1]) + (y[pb][2] * y[pb][2] + y[pb][3] * y[pb][3]);
        ss += shflx(ss, 16, lane); ss += shflx(ss, 32, lane);
        const float rstd = rsqrtf(ss * (1.0f / 64.0f) + EPS);
#pragma unroll
        for (int pb = 0; pb < 4; ++pb) { const int col = h * 64 + 16 * pb + 4 * q; const u32x2 gg = zg[pb];
            f32x4 o; o[0] = y[pb][0] * rstd * siluf_(bflo(gg.x)); o[1] = y[pb][1] * rstd * siluf_(bfhi(gg.x)); o[2] = y[pb][2] * rstd * siluf_(bflo(gg.y)); o[3] = y[pb][3] * rstd * siluf_(bfhi(gg.y));
            u32x2 w; w.x = cvt_pk_bf16(o[0], o[1]); w.y = cvt_pk_bf16(o[2], o[3]); *(u32x2*)(c.YC + (size_t)row * 512 + col) = w; }
    }
    __syncthreads();
}
__device__ __forceinline__ void la_scan_item(const LaCtx c, int item, int tid) {
    const int quarter = item & 3, seq = item >> 2;
    const int dir = seq & 1;
    unsigned* base = (unsigned*)(c.ST + (size_t)seq * 64 * 4096 + quarter * 1024) + tid;
    const float* dec = c.DEC + seq * 64;
    float s0 = 0.f, s1 = 0.f;
#pragma unroll 1
    for (int b = 0; b < 2; ++b) {
        unsigned r[32];
#pragma unroll
        for (int k = 0; k < 32; ++k) { const int o = b * 32 + k; const int ci = dir ? (63 - o) : o; r[k] = base[(size_t)ci * 2048]; }
#pragma unroll
        for (int k = 0; k < 32; ++k) { const int o = b * 32 + k; const int ci = dir ? (63 - o) : o; const float lo = bflo(r[k]), hi = bfhi(r[k]);
            base[(size_t)ci * 2048] = cvt_pk_bf16(s0, s1); const float d = dec[ci]; s0 = d * s0 + lo; s1 = d * s1 + hi; }
    }
}
__device__ __forceinline__ void s5_scan_item(LAS unsigned char* lds, const S5P p, const float* SC, bf16_t* UG, int item, int tid) {
    const int wave = __builtin_amdgcn_readfirstlane(tid >> 6), lane = tid & 63;
    const int dir = item & 1, g = (item >> 1) % 24, bb = item / 48;
    float lre, lim, step; s5_lam(p, dir, g, lane, lre, lim, step);
    float Lr, Li, Sr, Si; cpowf_(lre, lim, step, 16.0f, Lr, Li); cpowf_(lre, lim, step, 1024.0f, Sr, Si);
    const size_t rbase = (size_t)g * 1024 + bb * 512;
    float hr = 0.f, hi = 0.f;
#pragma unroll 1
    for (int b = 0; b < 4; ++b) {
        float re[16], im[16];
#pragma unroll
        for (int k = 0; k < 16; ++k) { const int o = wave * 64 + b * 16 + k; const int ci = dir ? (511 - o) : o; const size_t row = rbase + ci;
            re[k] = SC[row * 256 + dir * 128 + lane]; im[k] = SC[row * 256 + dir * 128 + 64 + lane]; }
#pragma unroll
        for (int k = 0; k < 16; ++k) { const float nr = Lr * hr - Li * hi + re[k], ni = Lr * hi + Li * hr + im[k]; hr = nr; hi = ni; }
    }
    LAS float* totr = (LAS float*)lds; LAS float* toti = totr + 512;
    totr[wave * 64 + lane] = hr; toti[wave * 64 + lane] = hi;
    __syncthreads();
    float Hr = 0.f, Hi = 0.f;
#pragma unroll
    for (int j = 0; j < 7; ++j) if (j < wave) { const float tr = totr[j * 64 + lane], ti = toti[j * 64 + lane]; const float nr = Sr * Hr - Si * Hi + tr, ni = Sr * Hi + Si * Hr + ti; Hr = nr; Hi = ni; }
#pragma unroll 1
    for (int b = 0; b < 4; ++b) {
        float re[16], im[16];
#pragma unroll
        for (int k = 0; k < 16; ++k) { const int o = wave * 64 + b * 16 + k; const int ci = dir ? (511 - o) : o; const size_t row = rbase + ci;
            re[k] = SC[row * 256 + dir * 128 + lane]; im[k] = SC[row * 256 + dir * 128 + 64 + lane]; }
#pragma unroll
        for (int k = 0; k < 16; ++k) { const int o = wave * 64 + b * 16 + k; const int ci = dir ? (511 - o) : o; const size_t row = rbase + ci;
            UG[row * 512 + 256 + dir * 128 + lane] = (bf16_t)f2bf(Hr); UG[row * 512 + 256 + dir * 128 + 64 + lane] = (bf16_t)f2bf(Hi);
            const float nr = Lr * Hr - Li * Hi + re[k], ni = Lr * Hi + Li * Hr + im[k]; Hr = nr; Hi = ni; }
    }
    __syncthreads();
}


constexpr size_t WS_BAR = 1 * MiB;
#define XB_TMO      128
#define XB_XCNT(j)  (256  + 64 * (j))
#define XB_XSUB(j)  (1280 + 64 * (j))
#define XB_XGEN(j)  (2304 + 64 * (j))
#define XB_TOP      3328
#define XB_TOPGEN   3392
#define XCD_BAR_WORDS 3456
#define XB_SPIN_CAP (1u << 22)
__device__ __forceinline__ unsigned xb_ld(unsigned* p)              { return __hip_atomic_load(p, __ATOMIC_RELAXED, __HIP_MEMORY_SCOPE_AGENT); }
__device__ __forceinline__ unsigned xb_add(unsigned* p, unsigned v) { return __hip_atomic_fetch_add(p, v, __ATOMIC_RELAXED, __HIP_MEMORY_SCOPE_AGENT); }
__device__ __forceinline__ unsigned xb_xcc_id() { return (unsigned)__builtin_amdgcn_s_getreg((3 << 11) | 20) & 0xFu; }
#define XB_SPIN(cond, bar) do { unsigned _sp = 0; while (cond) { __builtin_amdgcn_s_sleep(1); \
    if ((++_sp & 255u) == 0u) { if (xb_ld(&(bar)[XB_TMO])) break; if (_sp > XB_SPIN_CAP) { atomicAdd(&(bar)[XB_TMO], 1u); break; } } } } while (0)
__device__ __forceinline__ void xcd_barrier_complete(unsigned* bar, unsigned x, unsigned G, unsigned& nloc, unsigned& nx) {
    unsigned sum, cnt, mine, sp = 0u;
    for (;;) {
        sum = 0u; cnt = 0u; mine = 0u;
#pragma unroll
        for (unsigned j = 0; j < 16; ++j) { const unsigned c = xb_ld(&bar[XB_XCNT(j)]); sum += c; cnt += (c > 0u) ? 1u : 0u; mine = (j == x) ? c : mine; }
        if (sum == G) break;
        __builtin_amdgcn_s_sleep(1);
        if ((++sp & 255u) == 0u) { if (xb_ld(&bar[XB_TMO])) break; if (sp > XB_SPIN_CAP) { atomicAdd(&bar[XB_TMO], 1u); break; } }
    }
    nloc = mine > 0u ? mine : 1u; nx = cnt > 0u ? cnt : 1u;
}
__device__ __forceinline__ void xcd_barrier(unsigned* bar, volatile LAS unsigned* st, bool t0, unsigned G) {
    asm volatile("s_waitcnt vmcnt(0)" ::: "memory");
    __syncthreads();
    if (t0) {
        const unsigned x = xb_xcc_id();
        __builtin_amdgcn_s_waitcnt(0);
        unsigned nloc = st[0], nx = st[1];
        if (nloc == 0u) { xcd_barrier_complete(bar, x, G, nloc, nx); st[0] = nloc; st[1] = nx; }
        const unsigned old = xb_add(&bar[XB_XSUB(x)], 1u);
        const unsigned gen = old / nloc;
        if (old + 1u == (gen + 1u) * nloc) {
            __builtin_amdgcn_fence(__ATOMIC_RELEASE, "agent");
            asm volatile("s_waitcnt vmcnt(0)" ::: "memory");
            const unsigned og = xb_add(&bar[XB_TOP], 1u);
            const unsigned tg = og / nx;
            if (og + 1u == (tg + 1u) * nx) xb_add(&bar[XB_TOPGEN], 1u);
            else XB_SPIN(xb_ld(&bar[XB_TOPGEN]) == tg, bar);
            __builtin_amdgcn_fence(__ATOMIC_ACQUIRE, "agent");
            xb_add(&bar[XB_XGEN(x)], 1u);
            asm volatile("s_waitcnt vmcnt(0)" ::: "memory");
        } else {
            XB_SPIN(xb_ld(&bar[XB_XGEN(x)]) == gen, bar);
            __builtin_amdgcn_fence(__ATOMIC_ACQUIRE, "agent");
            asm volatile("s_waitcnt vmcnt(0)" ::: "memory");
        }
    }
    __syncthreads();
}


__device__ __forceinline__ S5P make_s5p(KArgP ap, int layer) {
    S5P sp; sp.lre = ap->in[15] + layer * 3072; sp.lim = ap->in[16] + layer * 3072; sp.lstep = ap->in[17] + layer * 48; sp.bre = ap->in[18] + layer * 24576; sp.bim = ap->in[19] + layer * 24576;
    sp.cre = ap->in[20] + layer * 49152; sp.cim = ap->in[21] + layer * 49152; sp.d = ap->in[22] + layer * 384; return sp;
}
__device__ __forceinline__ LaCtx make_lactx(KArgP ap, unsigned char* ws, int layer) {
    LaCtx lc; lc.P = WSP(bf16_t, WS_P); lc.DT = WSP(float, WS_DT); lc.ST = WSP(bf16_t, WS_ST); lc.DEC = WSP(float, WS_DEC); lc.YA = WSP(bf16_t, WS_YA); lc.YC = WSP(bf16_t, WS_YC);
    lc.rss = WSP(u64_t, WS_RS) + (size_t)(7 + layer) * T_ALL;
    lc.conv_w = ap->in[8] + layer * 5 * 768; lc.conv_b = ap->in[9] + layer * 768; lc.dt_bias = ap->in[10] + layer * 16; lc.a_log = ap->in[11] + layer * 16; lc.dskip = ap->in[12] + layer * 8;
    return lc;
}

__global__ void __launch_bounds__(512, 2) mega_fwd(Args a_unused) {
    extern __shared__ __attribute__((aligned(16))) unsigned char lds_raw[];
    LAS unsigned char* lds0 = (LAS unsigned char*)lds_raw;
    cg::grid_group grid = cg::this_grid();
#define GSYNC() do { PHASE(); TID_LOCAL(); xcd_barrier(WSP(unsigned, WS_BAR), (volatile LAS unsigned*)(lds + 131072 + 512), tid == 0, (unsigned)G); } while (0)
    const int wave0 = __builtin_amdgcn_readfirstlane((int)threadIdx.x >> 6);
    { if (threadIdx.x < 2) ((volatile LAS unsigned*)(lds0 + 131072 + 512))[threadIdx.x] = 0u; __syncthreads();
      KArgP ap0 = (KArgP)__builtin_amdgcn_kernarg_segment_ptr(); unsigned* bar0 = (unsigned*)(ap0->ws + WS_BAR); if (threadIdx.x == 0) (void)xb_add(&bar0[XB_XCNT(xb_xcc_id())], 1u); }

    { PHASE(); TID_LOCAL();
      u64_t* RS = WSP(u64_t, WS_RS); bf16_t* XB = WSP(bf16_t, WS_XB); float* ROPEC = WSP(float, WS_ROPE); float* ROPES = ROPEC + SEQ * 32; const float* xin = ap->in[0];
      for (int m = gw; m < T_ALL; m += 2 * NGW) {
        const int m2 = m + NGW; const bool has2 = m2 < T_ALL;
        const float* xr = xin + (size_t)m * DM + lane; const float* xr2 = xin + (size_t)(has2 ? m2 : m) * DM + lane;
        float va[16], vb[16];
#pragma unroll
        for (int j = 0; j < 16; ++j) { va[j] = xr[64 * j]; vb[j] = xr2[64 * j]; }
        bf16_t* xb = XB + (size_t)m * DM + lane; bf16_t* xb2 = XB + (size_t)m2 * DM + lane; float s = 0.f, s2 = 0.f;
#pragma unroll
        for (int j = 0; j < 16; ++j) { s += va[j] * va[j]; xb[64 * j] = (bf16_t)f2bf(va[j]); s2 += vb[j] * vb[j]; if (has2) xb2[64 * j] = (bf16_t)f2bf(vb[j]); }
        s = wave_sum(s, lane); s2 = wave_sum(s2, lane);
        if (lane == 0) { RS[m] = (u64_t)(s * RS_SCALE); if (has2) RS[m2] = (u64_t)(s2 * RS_SCALE); }
      }
      for (int i = gt; i < 8 * T_ALL; i += NGT) RS[T_ALL + i] = 0ull;
      for (int i = gt; i < SEQ * 32; i += NGT) { const int pos = i >> 5, j = i & 31; double inv = 1.0; for (int q = 0; q < j; ++q) inv *= 0.74989420933245582730; const double rev = (double)pos * inv * 0.15915494309189533577; const float fr_ = (float)(rev - floor(rev)); ROPEC[i] = __builtin_amdgcn_cosf(fr_); ROPES[i] = __builtin_amdgcn_sinf(fr_); }
    }

    for (int layer = 0; layer < 2; ++layer) {
        { PHASE(); TID_LOCAL();
            LAS float* scr = (LAS float*)(lds + wave * 16384);
            constexpr int I_GU = 16 * 176, I_D = 44 * 32, I_IN = 16 * 216, I_A = 8 * 32, I_B = 6 * 32, I_GLU = 6 * 24, I_C = 8 * 32, I_O = 16 * 32;
            constexpr int NITEMS = 2 * I_GU + 2 * I_D + I_IN + I_A + I_B + I_GLU + I_C + I_O;
            for (int it = gw; it < NITEMS; it += NGW) {
                int r = it;
                if (r < I_GU) { TrSrc s{FF, 2 * FF, 1}; tr_item(ap->in[2] + (size_t)layer * DM * FF, ap->in[3] + (size_t)layer * DM * FF, ap->in[1] + layer * DM, s, DM, WSP(bf16_t, WS_WGU1), scr, r, lane); continue; } r -= I_GU;
                if (r < I_GU) { TrSrc s{FF, 2 * FF, 1}; tr_item(ap->in[30] + (size_t)layer * DM * FF, ap->in[31] + (size_t)layer * DM * FF, ap->in[29] + layer * DM, s, DM, WSP(bf16_t, WS_WGU2), scr, r, lane); continue; } r -= I_GU;
                if (r < I_D) { TrSrc s{DM, DM, 0}; tr_item(ap->in[4] + (size_t)layer * DM * FF, nullptr, nullptr, s, FF, WSP(bf16_t, WS_WD1), scr, r, lane); continue; } r -= I_D;
                if (r < I_D) { TrSrc s{DM, DM, 0}; tr_item(ap->in[32] + (size_t)layer * DM * FF, nullptr, nullptr, s, FF, WSP(bf16_t, WS_WD2), scr, r, lane); continue; } r -= I_D;
                if (r < I_IN) { TrSrc s{6800, NP, 2}; tr_item(ap->in[6] + (size_t)layer * DM * 6800, nullptr, ap->in[5] + layer * DM, s, DM, WSP(bf16_t, WS_WIN), scr, r, lane); continue; } r -= I_IN;
                if (r < I_A) { TrSrc s{DM, DM, 0}; tr_item(ap->in[14] + (size_t)layer * 512 * DM, nullptr, ap->in[13] + layer * 512, s, 512, WSP(bf16_t, WS_WA), scr, r, lane); continue; } r -= I_A;
                if (r < I_B) { TrSrc s{DM, DM, 0}; tr_item(ap->in[25] + (size_t)layer * 384 * DM, nullptr, nullptr, s, 384, WSP(bf16_t, WS_WB), scr, r, lane); continue; } r -= I_B;
                if (r < I_GLU) { TrSrc s{384, 768, 1}; tr_item(ap->in[23] + (size_t)layer * 384 * 384, ap->in[24] + (size_t)layer * 384 * 384, nullptr, s, 384, WSP(bf16_t, WS_WGLU), scr, r, lane); continue; } r -= I_GLU;
                if (r < I_C) { TrSrc s{DM, DM, 0}; tr_item(ap->in[27] + (size_t)layer * 512 * DM, nullptr, ap->in[26] + layer * 512, s, 512, WSP(bf16_t, WS_WC), scr, r, lane); continue; } r -= I_C;
                { TrSrc s{DM, DM, 0}; tr_item(ap->in[28] + (size_t)layer * DM * DM, nullptr, nullptr, s, DM, WSP(bf16_t, WS_WOUT), scr, r, lane); }
            }
        }
        { PHASE(); TID_LOCAL(); const S5P sp = make_s5p(ap, layer); float* KTAB = WSP(float, WS_KTAB);
            for (int i = gt; i < 24 * 2 * 16 * 256; i += NGT) {
                const int cc = i & 15, c = (i >> 4) & 15, tau = (i >> 8) & 15, dir = (i >> 12) & 1, g = i >> 13; float sum = 0.f;
                for (int pp = 0; pp < 64; ++pp) { float lre, lim, step; s5_lam(sp, dir, g, pp, lre, lim, step); float cr, ci; s5_coef(lre, lim, step, cr, ci);
                    float pr, pi; cpowf_(lre, lim, step, (float)tau, pr, pi); const float mr = pr * cr - pi * ci, mi = pr * ci + pi * cr;
                    const float br = sp.bre[(g * 64 + pp) * 16 + cc], bi = sp.bim[(g * 64 + pp) * 16 + cc]; const float mbr = mr * br - mi * bi, mbi = mr * bi + mi * br;
                    const float c_r = sp.cre[((dir * 24 + g) * 16 + c) * 64 + pp], c_i = sp.cim[((dir * 24 + g) * 16 + c) * 64 + pp];
                    sum += c_r * mbr - c_i * mbi; }
                KTAB[i] = sum;
            }
        }
        { PHASE(); TID_LOCAL(); const S5P sp = make_s5p(ap, layer); bf16_t* S5S = WSP(bf16_t, WS_S5S); bf16_t* S5Y = WSP(bf16_t, WS_S5Y);
            for (int i = gt; i < 24 * 256 * 256; i += NGT) {
                const int k = i & 255, n = (i >> 8) & 255, g = i >> 16;
                { const int s = k >> 4, cc = k & 15; const int dir = n >> 7, isim = (n >> 6) & 1, pp = n & 63; const float tau = dir == 0 ? (float)(15 - s) : (float)s;
                  float lre, lim, step; s5_lam(sp, dir, g, pp, lre, lim, step); float cr, ci; s5_coef(lre, lim, step, cr, ci); float pr, pi; cpowf_(lre, lim, step, tau, pr, pi);
                  const float mr = pr * cr - pi * ci, mi = pr * ci + pi * cr; const float br = sp.bre[(g * 64 + pp) * 16 + cc], bi = sp.bim[(g * 64 + pp) * 16 + cc];
                  const float val = isim ? (mr * bi + mi * br) : (mr * br - mi * bi); S5S[i] = (bf16_t)f2bf(val); }
                { const int t = n >> 4, c = n & 15; const int dir = k >> 7, isim = (k >> 6) & 1, pp = k & 63; const float tau = dir == 0 ? (float)(t + 1) : (float)(16 - t);
                  float lre, lim, step; s5_lam(sp, dir, g, pp, lre, lim, step); float pr, pi; cpowf_(lre, lim, step, tau, pr, pi);
                  const float c_r = sp.cre[((dir * 24 + g) * 16 + c) * 64 + pp], c_i = sp.cim[((dir * 24 + g) * 16 + c) * 64 + pp];
                  const float val = isim ? -(c_r * pi + c_i * pr) : (c_r * pr - c_i * pi); S5Y[((size_t)(g * 256 + n)) * 512 + 256 + k] = (bf16_t)f2bf(val); }
            }
        }
        if (layer == 0) { asm volatile("s_waitcnt vmcnt(0) lgkmcnt(0)" ::: "memory"); grid.sync(); asm volatile("" ::: "memory"); }
        else GSYNC();
        { PHASE(); TID_LOCAL(); const float* KTAB = WSP(float, WS_KTAB); bf16_t* S5Y = WSP(bf16_t, WS_S5Y); const float* dd = ap->in[22] + layer * 384;
        for (int i = gt; i < 24 * 256 * 256; i += NGT) {
            const int k = i & 255, n = (i >> 8) & 255, g = i >> 16; const int s = k >> 4, cc = k & 15, t = n >> 4, c = n & 15; float v = 0.f;
            if (t >= s) v += KTAB[(((g * 2 + 0) * 16 + (t - s)) * 16 + c) * 16 + cc];
            if (s >= t) v += KTAB[(((g * 2 + 1) * 16 + (s - t)) * 16 + c) * 16 + cc];
            if (s == t && c == cc) v += dd[g * 16 + c];
            S5Y[((size_t)(g * 256 + n)) * 512 + k] = (bf16_t)f2bf(v);
        } }

        for (int f = 0; f < 2; ++f) {
            const int sidx = layer * 2 + f;
            const int rs_in = (sidx == 0) ? 0 : (sidx == 1 ? 2 : (sidx == 2 ? 3 : 5));
            const int rs_out = rs_in + 1;
            { PHASE(); TID_LOCAL(); pg8::Gemm g{WSP(bf16_t, WS_XB), WSP(bf16_t, f ? WS_WGU2 : WS_WGU1), DM, DM, DM}; pg8::SchedFull S; S.init(T_ALL / 256, 2 * FF / 256, G, bid);
              EpiGU E{rs_in}; pg8::gemm_phase(lds, g, S, E, tid); }
            GSYNC();
            { PHASE(); TID_LOCAL(); pg8::Gemm g{WSP(bf16_t, WS_H), WSP(bf16_t, f ? WS_WD2 : WS_WD1), FF, FF, FF}; pg8::SchedFull S; S.init(T_ALL / 256, DM / 256, G, bid);
              EpiRes E{(sidx == 0) ? 1 : 0, 0, rs_out, 0.5f}; pg8::gemm_phase(lds, g, S, E, tid); }
            GSYNC();
            if (f == 1) break;
            const int rs_b = rs_out, rs_c = rs_out + 1;
            for (int half = 0; half < 2; ++half) {
                const int row0 = half * TH;
                { PHASE(); TID_LOCAL(); pg8::Gemm g{WSP(bf16_t, WS_XB) + (size_t)row0 * DM, WSP(bf16_t, WS_WIN), DM, DM, DM}; pg8::SchedFull S; S.init(TH / 256, NP / 256, G, bid);
                  EpiInproj E{row0, rs_b, layer};
                  pg8::gemm_phase(lds, g, S, E, tid); }
                GSYNC();
                { PHASE(); TID_LOCAL(); pg8::Gemm g{WSP(bf16_t, WS_UG), WSP(bf16_t, WS_S5S), 512, 256, 256}; pg8::SchedGrp S; S.init(4, 1, 24, G, bid); EpiS5S E{0}; pg8::gemm_phase(lds, g, S, E, tid); }
                { PHASE(); TID_LOCAL(); const LaCtx lc = make_lactx(ap, ws, layer); la_stage_conv_all(lds, lc, tid);
                  for (int un = bid; un < 2048; un += G) { const int h = un & 7, ci = (un >> 3) & 63, bb = (un >> 9) & 1, m = un >> 10; la_unit_A(lds, lc, m, bb, ci, h, tid); } }
                GSYNC();
                { PHASE(); TID_LOCAL(); const LaCtx lc = make_lactx(ap, ws, layer);
                  for (int it = bid; it < 256; it += G) la_scan_item(lc, it, tid); }
                { PHASE(); TID_LOCAL(); const S5P sp = make_s5p(ap, layer);
                  for (int it = bid; it < 96; it += G) s5_scan_item(lds, sp, WSP(float, WS_SC), WSP(bf16_t, WS_UG), it, tid); }
                GSYNC();
                { PHASE(); TID_LOCAL(); pg8::Gemm g{WSP(bf16_t, WS_UG), WSP(bf16_t, WS_S5Y), 512, 512, 512}; pg8::SchedGrp S; S.init(4, 1, 24, G, bid); EpiS5Y E{0}; pg8::gemm_phase(lds, g, S, E, tid); }
                { PHASE(); TID_LOCAL(); const LaCtx lc = make_lactx(ap, ws, layer); la_stage_conv_all(lds, lc, tid);
                  for (int un = bid; un < 2048; un += G) { const int h = un & 7, ci = (un >> 3) & 63, bb = (un >> 9) & 1, m = un >> 10; la_unit_C(lds, lc, m, bb, ci, h, tid, row0); } }
                GSYNC();
                { PHASE(); TID_LOCAL(); pg8::Gemm g{WSP(bf16_t, WS_P) + PC_YBP, WSP(bf16_t, WS_WGLU), NP, 384, 384}; pg8::SchedFull S; S.init(TH / 256, 3, G, bid); EpiGLU E{0}; pg8::gemm_phase(lds, g, S, E, tid); }
                GSYNC();
                { PHASE(); TID_LOCAL(); pg8::SchedFull S; S.init(TH / 256, DM / 256, G, bid);
                  pg8::Gemm g{WSP(bf16_t, WS_YA), WSP(bf16_t, WS_WA), 512, 512, 512}; EpiBr E{PC_GATE, (7 + layer) * T_ALL + row0, 1}; pg8::gemm_phase(lds, g, S, E, tid); }
                { PHASE(); TID_LOCAL(); pg8::SchedFull S; S.init(TH / 256, DM / 256, G, bid);
                  pg8::Gemm g{WSP(bf16_t, WS_YB), WSP(bf16_t, WS_WB), 384, 384, 384}; EpiBr E{PC_GATE + 1024, -1, 0}; pg8::gemm_phase(lds, g, S, E, tid); }
                { PHASE(); TID_LOCAL(); pg8::SchedFull S; S.init(TH / 256, DM / 256, G, bid);
                  pg8::Gemm g{WSP(bf16_t, WS_YC), WSP(bf16_t, WS_WC), 512, 512, 512}; EpiBr E{PC_GATE + 2048, -1, 0}; pg8::gemm_phase(lds, g, S, E, tid); }
                GSYNC();
                { PHASE(); TID_LOCAL(); pg8::Gemm g{WSP(bf16_t, WS_MIX), WSP(bf16_t, WS_WOUT), DM, DM, DM}; pg8::SchedFull S; S.init(TH / 256, DM / 256, G, bid);
                  EpiRes E{0, row0, rs_c, 1.0f}; pg8::gemm_phase(lds, g, S, E, tid); }
                GSYNC();
            }
        }
    }
    { PHASE(); TID_LOCAL(); float* xout = ap->out; const u64_t* RS6 = WSP(u64_t, WS_RS) + (size_t)6 * T_ALL; const float* fn = ap->in[33]; const bf16_t* XB = WSP(bf16_t, WS_XB);
    for (int m = gw; m < T_ALL; m += NGW) {
        f32x4* xr = (f32x4*)(xout + (size_t)m * DM) + lane; const u32x2* xb = (const u32x2*)(XB + (size_t)m * DM) + lane; const float* gn = fn + 4 * lane;
        const float rstd = rsqrtf((float)RS6[m] * (RS_INV / DM) + EPS);
#pragma unroll
        for (int j = 0; j < 4; ++j) { const u32x2 w = xb[64 * j]; f32x4 v; v[0] = bflo(w.x); v[1] = bfhi(w.x); v[2] = bflo(w.y); v[3] = bfhi(w.y);
            f32x4 gg; gg[0] = gn[256 * j]; gg[1] = gn[256 * j + 1]; gg[2] = gn[256 * j + 2]; gg[3] = gn[256 * j + 3]; xr[64 * j] = v * rstd * gg; }
    } }
}

extern "C" void kernel_launch(void* const* d_in, const int* in_sizes, int n_in, void* d_out, int out_size, void* d_ws, size_t ws_size, hipStream_t stream) {
    static int grid = 0;
    if (grid == 0) {
        if (n_in != 34 || ws_size < WS_END) { fprintf(stderr, "kernel_launch: unexpected n_in %d / ws %zu (need %zu)\n", n_in, ws_size, (size_t)WS_END); grid = -1; return; }
        int dev = 0, cus = 0, per_cu = 0;
        (void)hipGetDevice(&dev); (void)hipDeviceGetAttribute(&cus, hipDeviceAttributeMultiprocessorCount, dev);
        if (hipFuncSetAttribute((const void*)mega_fwd, hipFuncAttributeMaxDynamicSharedMemorySize, LDS_BYTES) != hipSuccess) { fprintf(stderr, "kernel_launch: hipFuncSetAttribute failed\n"); grid = -1; return; }
        if (hipOccupancyMaxActiveBlocksPerMultiprocessor(&per_cu, (const void*)mega_fwd, 512, LDS_BYTES) != hipSuccess || per_cu < 1) { fprintf(stderr, "kernel_launch: occupancy query says %d\n", per_cu); per_cu = 1; }
        (void)hipGetLastError();
        grid = cus * 1;
        if (grid <= 0) grid = 256;
    }
    if (grid < 0) return;
    (void)hipMemsetAsync((char*)d_ws + WS_BAR, 0, 16384, stream);
    Args a{};
    for (int i = 0; i < 34; ++i) a.in[i] = (const float*)d_in[i];
    a.out = (float*)d_out; a.ws = (unsigned char*)d_ws;
    void* args[] = {&a};
    hipError_t e = hipLaunchCooperativeKernel((const void*)mega_fwd, dim3(grid), dim3(512), args, LDS_BYTES, stream);
    if (e != hipSuccess) fprintf(stderr, "kernel_launch: cooperative launch failed: %s (grid %d)\n", hipGetErrorString(e), grid);
}
```

```cpp
#include <hip/hip_runtime.h>
#include <hip/hip_cooperative_groups.h>
#include <cstdio>
#include <cstdint>
namespace cg = cooperative_groups;

#define LAS __attribute__((address_space(3)))
typedef unsigned short bf16_t;
typedef short bf16x8 __attribute__((ext_vector_type(8)));
typedef float f32x4 __attribute__((ext_vector_type(4)));
typedef float f32x8 __attribute__((ext_vector_type(8)));
typedef unsigned u32x4 __attribute__((ext_vector_type(4)));
typedef unsigned u32x2 __attribute__((ext_vector_type(2)));
typedef unsigned long long u64_t;
#define RS_SCALE 16777216.0f
#define RS_INV (1.0f / 16777216.0f)

constexpr int T_ALL = 32768, DM = 1024, TH = 16384, SEQ = 8192, FF = 2816, NP = 6912;
constexpr float EPS = 1e-6f;
constexpr int PC_Z = 0, PC_XBC = 512, PC_YBP = 1280, PC_Q = 1792, PC_K = 2304, PC_V = 2816, PC_G = 3328, PC_GATE = 3840;

constexpr size_t MiB = 1u << 20;
constexpr size_t WS_RS = 505 * MiB;
constexpr size_t WS_DEC = 3 * MiB / 2;
constexpr size_t WS_ROPE = 2 * MiB;
constexpr size_t WS_WGU1 = 4 * MiB, WS_WD1 = 15 * MiB, WS_WIN = 20 * MiB + MiB / 2, WS_WA = 34 * MiB, WS_WB = 35 * MiB,
                 WS_WGLU = 35 * MiB + 3 * MiB / 4, WS_WC = 36 * MiB + MiB / 2, WS_WOUT = 37 * MiB + MiB / 2, WS_WGU2 = 39 * MiB + MiB / 2,
                 WS_WD2 = 50 * MiB + MiB / 2, WS_S5S = 56 * MiB, WS_S5Y = 59 * MiB, WS_KTAB = 65 * MiB;
constexpr size_t WS_XB = 68 * MiB;
constexpr size_t WS_H = 132 * MiB;
constexpr size_t WS_P = 132 * MiB;
constexpr size_t WS_YA = 348 * MiB, WS_YB = 364 * MiB, WS_YC = 376 * MiB, WS_MIX = 392 * MiB, WS_ST = 424 * MiB,
                 WS_UG = 456 * MiB, WS_SC = 480 * MiB, WS_DT = 504 * MiB, WS_END = 508 * MiB;
constexpr int LDS_BYTES = 147456;

typedef __bf16 bf16v2_t __attribute__((ext_vector_type(2)));
typedef float f32v2_t __attribute__((ext_vector_type(2)));
__device__ __forceinline__ unsigned cvt_pk_bf16(float lo, float hi) { f32v2_t v = {lo, hi}; bf16v2_t b = __builtin_convertvector(v, bf16v2_t); return __builtin_bit_cast(unsigned, b); }
__device__ __forceinline__ unsigned f2bf(float f) { unsigned u = __builtin_bit_cast(unsigned, f); return (u + 0x7fffu + ((u >> 16) & 1u)) >> 16; }
__device__ __forceinline__ float bflo(unsigned u) { return __builtin_bit_cast(float, u << 16); }
__device__ __forceinline__ float bfhi(unsigned u) { return __builtin_bit_cast(float, u & 0xffff0000u); }
__device__ __forceinline__ float rcpf_(float x) { return __builtin_amdgcn_rcpf(x); }
__device__ __forceinline__ float sigmoidf_(float x) { return rcpf_(1.0f + __expf(-x)); }
__device__ __forceinline__ float shflx(float v, int mask, int lane) { return __builtin_bit_cast(float, __builtin_amdgcn_ds_bpermute((lane ^ mask) << 2, __builtin_bit_cast(int, v))); }
__device__ __forceinline__ void sincos_rev(float rev, float& s, float& c) { const float f = rev - floorf(rev); s = __builtin_amdgcn_sinf(f); c = __builtin_amdgcn_cosf(f); }
__device__ __forceinline__ float siluf_(float x) { return x * sigmoidf_(x); }
__device__ __forceinline__ float softplusf_(float x) { return fmaxf(x, 0.f) + __logf(1.0f + __expf(-fabsf(x))); }
__device__ __forceinline__ float gelu_tanh(float x) { const float u = 0.7978845608028654f * (x + 0.044715f * x * x * x); const float t = 1.0f - 2.0f * rcpf_(__expf(2.0f * u) + 1.0f); return 0.5f * x * (1.0f + t); }
__device__ __forceinline__ f32x8 unpack8(u32x4 v) { f32x8 o; o[0] = bflo(v.x); o[1] = bfhi(v.x); o[2] = bflo(v.y); o[3] = bfhi(v.y); o[4] = bflo(v.z); o[5] = bfhi(v.z); o[6] = bflo(v.w); o[7] = bfhi(v.w); return o; }
__device__ __forceinline__ u32x4 pack8(f32x4 a, f32x4 b) { u32x4 w; w.x = cvt_pk_bf16(a[0], a[1]); w.y = cvt_pk_bf16(a[2], a[3]); w.z = cvt_pk_bf16(b[0], b[1]); w.w = cvt_pk_bf16(b[2], b[3]); return w; }
__device__ __forceinline__ float wave_sum(float v, int lane) {
#pragma unroll
    for (int o = 1; o < 64; o <<= 1) v += shflx(v, o, lane);
    return v;
}

namespace pg8 {
constexpr int BM = 256, BK = 64, HALF = 128, HTB = HALF * BK * 2, NXCD = 8, WGM = 8;
__device__ __forceinline__ int lds_byte(int r, int c) { const int st = (r >> 4) * 2 + (c >> 5), rr = r & 15, cc = c & 31, ob = rr * 64 + cc * 2; return st * 1024 + (ob ^ (((ob >> 9) & 1) << 5)); }
__device__ __forceinline__ void stage_rc(int b, int& R, int& C) { const int st = b / 1024, sb = b % 1024, swz = sb ^ (((sb >> 9) & 1) << 5); R = (st >> 1) * 16 + swz / 64; C = (st & 1) * 32 + (swz % 64) / 2; }
__device__ __forceinline__ int perm32(int rho) { const int n = rho >> 4, i = rho & 15; return 8 * (i >> 2) + 4 * n + (i & 3); }

struct Unit { int pm, pn; };
struct Gemm { const bf16_t* A; const bf16_t* Bt; int lda, ldb, K; };

struct SchedFull {
    int nM, nN, nwg, G, c;
    __device__ void init(int nM_, int nN_, int G_, int c_) { nM = nM_; nN = nN_; nwg = nM * nN; G = G_; c = c_; }
    __device__ bool next(int i, Unit& u) const {
        const long L = (long)i * G + c; if (L >= nwg) return false;
        int wgid = (int)L; { const int q = nwg / NXCD, r = nwg % NXCD, xcd = wgid % NXCD, off = wgid / NXCD; wgid = (xcd < r ? xcd * (q + 1) : r * (q + 1) + (xcd - r) * q) + off; }
        const int nig = WGM * nN, gid = wgid / nig, fm = gid * WGM, gsz = (nM - fm) < WGM ? (nM - fm) : WGM;
        u.pm = fm + ((wgid % nig) % gsz); u.pn = (wgid % nig) / gsz; return true;
    }
};
struct SchedGrp {
    int mt, nt, ng, G, c;
    __device__ void init(int mt_, int nt_, int ng_, int G_, int c_) { mt = mt_; nt = nt_; ng = ng_; G = G_; c = c_; }
    __device__ bool next(int i, Unit& u) const {
        const int L = i * G + c; if (L >= ng * mt * nt) return false;
        const int g = L / (mt * nt), r = L % (mt * nt); u.pm = g * mt + r / nt; u.pn = g * nt + r % nt; return true;
    }
};

template <class Epi, class Sched>
__device__ __forceinline__ void gemm_phase(LAS unsigned char* lds, const Gemm g, const Sched& S, const Epi& E, int tid) {
    const int wid = __builtin_amdgcn_readfirstlane(tid >> 6), lane = tid & 63, wr = wid >> 2, wc = wid & 3, fr = lane & 15, fq = lane >> 4;
    const int K = g.K, nt = K / BK;
    unsigned voffA[2], voffB[2];
#pragma unroll
    for (int i = 0; i < 2; ++i) { int R, C; stage_rc(tid * 16 + i * 8192, R, C); const int Rb = (R & ~31) + perm32(R & 31);
        voffA[i] = (unsigned)(R * g.lda + C) * 2u; voffB[i] = (unsigned)(Rb * g.ldb + C) * 2u; }
    const size_t kstep = (size_t)(BK * 2);
    const size_t hstepA = (size_t)HALF * g.lda * 2, hstepB = (size_t)HALF * g.ldb * 2;
    const size_t tstepA = 2 * hstepA, tstepB = 2 * hstepB;
    const unsigned ldsw = (unsigned)wid * 1024u;
    const int aoff = lds_byte(wr * 64 + fr, fq * 8), boff = lds_byte(wc * 32 + fr, fq * 8);
#define PG8_SA(b, h) (((b) * 2 + (h)) * HTB)
#define PG8_SB(b, h) ((4 + (b) * 2 + (h)) * HTB)
#define PG8_STAGE(bufoff, gbase, voff) do { _Pragma("unroll") for (int _i = 0; _i < 2; ++_i) \
        __builtin_amdgcn_global_load_lds((const unsigned*)((const char*)(gbase) + (voff)[_i]), (LAS unsigned*)(lds + (bufoff) + ldsw + _i * 8192), 16, 0, 0); } while (0)
#define PG8_LDA(dst, b, h) do { _Pragma("unroll") for (int m = 0; m < 4; ++m) _Pragma("unroll") for (int k = 0; k < 2; ++k) dst[m][k] = *(const LAS bf16x8*)(lds + PG8_SA(b, h) + aoff + m * 2048 + k * 1024); } while (0)
#define PG8_LDB(dst, b, h) do { _Pragma("unroll") for (int n = 0; n < 2; ++n) _Pragma("unroll") for (int k = 0; k < 2; ++k) dst[n][k] = *(const LAS bf16x8*)(lds + PG8_SB(b, h) + boff + n * 2048 + k * 1024); } while (0)
#define PG8_MMA(ai, bj, At, Bt) do { __builtin_amdgcn_s_setprio(1); _Pragma("unroll") for (int m = 0; m < 4; ++m) _Pragma("unroll") for (int n = 0; n < 2; ++n) _Pragma("unroll") for (int k = 0; k < 2; ++k) \
        acc[ai][bj][m][n] = __builtin_amdgcn_mfma_f32_16x16x32_bf16(Bt[n][k], At[m][k], acc[ai][bj][m][n], 0, 0, 0); __builtin_amdgcn_s_setprio(0); } while (0)
#define PG8_WAIT_V(n) asm volatile("s_waitcnt vmcnt(" #n ")" ::: "memory")
#define PG8_WAIT_L(n) asm volatile("s_waitcnt lgkmcnt(" #n ")" ::: "memory")
#define PG8_BAR __builtin_amdgcn_s_barrier()
#define PG8_SCHED __builtin_amdgcn_sched_barrier(0)
    Unit cur, nxt; int ui = 0;
    if (!S.next(0, cur)) return;
    f32x4 acc[2][2][4][2];
#pragma unroll
    for (int a = 0; a < 2; ++a)
#pragma unroll
        for (int b = 0; b < 2; ++b)
#pragma unroll
            for (int m = 0; m < 4; ++m)
#pragma unroll
                for (int n = 0; n < 2; ++n) acc[a][b][m][n] = (f32x4){0.f, 0.f, 0.f, 0.f};
    bf16x8 At[4][2], B0[2][2], B1[2][2];
    const char* cA = (const char*)g.A + (size_t)cur.pm * tstepA; const char* cB = (const char*)g.Bt + (size_t)cur.pn * tstepB;
    PG8_STAGE(PG8_SB(0, 0), cB, voffB); PG8_STAGE(PG8_SB(0, 1), cB + hstepB, voffB); PG8_STAGE(PG8_SA(0, 0), cA, voffA); PG8_STAGE(PG8_SA(0, 1), cA + hstepA, voffA);
    if (wr == 1) PG8_BAR;
    PG8_WAIT_V(2); PG8_BAR;
    PG8_STAGE(PG8_SB(1, 0), cB + kstep, voffB); PG8_STAGE(PG8_SA(1, 0), cA + kstep, voffA); PG8_STAGE(PG8_SB(1, 1), cB + hstepB + kstep, voffB);
    PG8_WAIT_V(6); PG8_BAR;
    for (;;) {
        const bool has_next = S.next(ui + 1, nxt);
        const char* nA = has_next ? (const char*)g.A + (size_t)nxt.pm * tstepA : cA; const char* nB = has_next ? (const char*)g.Bt + (size_t)nxt.pn * tstepB : cB;
        for (int t = 0; t < nt; t += 2) {
            const bool last = (t == nt - 2);
            const char* a1 = cA + (size_t)(t + 1) * kstep;
            const char* a2 = last ? nA : cA + (size_t)(t + 2) * kstep; const char* b2 = last ? nB : cB + (size_t)(t + 2) * kstep;
            const char* a3 = a2 + kstep; const char* b3 = b2 + kstep;
            PG8_LDB(B0, 0, 0); PG8_LDB(B1, 0, 1); PG8_SCHED; PG8_LDA(At, 0, 0); PG8_STAGE(PG8_SA(1, 1), a1 + hstepA, voffA);
            PG8_WAIT_V(8); PG8_WAIT_L(0); PG8_BAR; PG8_MMA(0, 0, At, B0); PG8_MMA(0, 1, At, B1); PG8_BAR; PG8_SCHED;
            PG8_LDA(At, 0, 1); PG8_STAGE(PG8_SB(0, 0), b2, voffB); PG8_STAGE(PG8_SB(0, 1), b2 + hstepB, voffB); PG8_STAGE(PG8_SA(0, 0), a2, voffA);
            PG8_WAIT_V(8); PG8_WAIT_L(0); PG8_BAR; PG8_MMA(1, 0, At, B0); PG8_MMA(1, 1, At, B1); PG8_BAR; PG8_SCHED;
            PG8_LDB(B0, 1, 0); PG8_LDB(B1, 1, 1); PG8_SCHED; PG8_LDA(At, 1, 0); PG8_STAGE(PG8_SA(0, 1), a2 + hstepA, voffA);
            PG8_WAIT_V(8); PG8_WAIT_L(0); PG8_BAR; PG8_MMA(0, 0, At, B0); PG8_MMA(0, 1, At, B1); PG8_BAR; PG8_SCHED;
            PG8_LDA(At, 1, 1); PG8_STAGE(PG8_SB(1, 0), b3, voffB); PG8_STAGE(PG8_SB(1, 1), b3 + hstepB, voffB); PG8_STAGE(PG8_SA(1, 0), a3, voffA);
            PG8_WAIT_V(8); PG8_WAIT_L(0); PG8_BAR; PG8_MMA(1, 0, At, B0); PG8_MMA(1, 1, At, B1); PG8_BAR; PG8_SCHED;
        }
        if (wr == 0) PG8_BAR;
        { int z_ = 0; asm volatile("" : "+s"(z_)); const int l2 = __builtin_amdgcn_mbcnt_hi(~0u, __builtin_amdgcn_mbcnt_lo(~0u, z_));
          E(acc, cur, wr, wc, l2 & 15, l2 >> 4); }
        if (!has_next) break;
#pragma unroll
        for (int a = 0; a < 2; ++a)
#pragma unroll
            for (int b = 0; b < 2; ++b)
#pragma unroll
                for (int m = 0; m < 4; ++m)
#pragma unroll
                    for (int n = 0; n < 2; ++n) acc[a][b][m][n] = (f32x4){0.f, 0.f, 0.f, 0.f};
        cur = nxt; cA = nA; cB = nB; ++ui;
        if (wr == 1) PG8_BAR;
    }
    PG8_WAIT_V(0);
    PG8_BAR;
#undef PG8_SA
#undef PG8_SB
#undef PG8_STAGE
#undef PG8_LDA
#undef PG8_LDB
#undef PG8_MMA
#undef PG8_WAIT_V
#undef PG8_WAIT_L
#undef PG8_BAR
#undef PG8_SCHED
}
}
using pg8::Unit;
typedef f32x4 Acc[2][2][4][2];

struct Args { const float* in[34]; float* out; unsigned char* ws; };
typedef const __attribute__((address_space(4))) Args* KArgP;
#define KARGS() KArgP ap = (KArgP)__builtin_amdgcn_kernarg_segment_ptr(); asm volatile("" : "+s"(ap)); unsigned char* ws = ap->ws; (void)ws
#define TID_LOCAL() int z_ = 0; asm volatile("" : "+s"(z_)); const int lane = __builtin_amdgcn_mbcnt_hi(~0u, __builtin_amdgcn_mbcnt_lo(~0u, z_)); int wave = wave0; asm volatile("" : "+s"(wave)); const int tid = wave * 64 + lane; const int gw = bid * 8 + wave, gt = bid * 512 + tid; (void)lane; (void)wave; (void)gw; (void)gt
#define WSP(type, off) ((type*)(ws + (off)))
#define PHASE() KARGS(); int bid = blockIdx.x, G = gridDim.x; asm volatile("" : "+s"(bid), "+s"(G)); LAS unsigned char* lds = lds0; asm volatile("" : "+s"(lds)); const int NGW = G * 8, NGT = G * 512; (void)NGW; (void)NGT
struct EpiGU {
    int rs_in;
    __device__ __forceinline__ void operator()(const Acc& acc, const Unit& u, int wr, int wc, int fr, int fq) const {
        KARGS(); bf16_t* H = WSP(bf16_t, WS_H); const u64_t* rs = WSP(u64_t, WS_RS) + (size_t)rs_in * T_ALL;
        const int rowb = u.pm * 256 + wr * 64 + fr; const int hc = u.pn * 128 + wc * 32 + fq * 8;
#pragma unroll
        for (int ai = 0; ai < 2; ++ai)
#pragma unroll
            for (int m = 0; m < 4; ++m) { const int row = rowb + ai * 128 + m * 16; const float rstd = rsqrtf((float)rs[row] * (RS_INV / DM) + EPS);
                f32x4 h0, h1;
#pragma unroll
                for (int i = 0; i < 4; ++i) { h0[i] = siluf_(acc[ai][0][m][0][i] * rstd) * (acc[ai][1][m][0][i] * rstd); h1[i] = siluf_(acc[ai][0][m][1][i] * rstd) * (acc[ai][1][m][1][i] * rstd); }
                *(u32x4*)(H + (size_t)row * FF + hc) = pack8(h0, h1); }
    }
};
struct EpiRes {
    int base_in; int row0; int rs_o; float coef;
    __device__ __forceinline__ void operator()(const Acc& acc, const Unit& u, int wr, int wc, int fr, int fq) const {
        KARGS(); (void)base_in;
        bf16_t* XB = WSP(bf16_t, WS_XB) + (size_t)row0 * DM; u64_t* rs_out = WSP(u64_t, WS_RS) + (size_t)rs_o * T_ALL + row0;
        const int rowb = u.pm * 256 + wr * 64 + fr; const int cl = u.pn * 256 + wc * 32 + 8 * fq;
#pragma unroll
        for (int ai = 0; ai < 2; ++ai)
#pragma unroll
            for (int m = 0; m < 4; ++m) { const int row = rowb + ai * 128 + m * 16; float ss = 0.f;
#pragma unroll
                for (int bj = 0; bj < 2; ++bj) { const size_t off = (size_t)row * DM + cl + bj * 128;
                    const f32x8 bv = unpack8(*(const u32x4*)(XB + off));
                    f32x4 x0, x1;
#pragma unroll
                    for (int i = 0; i < 4; ++i) { x0[i] = bv[i] + coef * acc[ai][bj][m][0][i]; x1[i] = bv[4 + i] + coef * acc[ai][bj][m][1][i]; }
                    *(u32x4*)(XB + off) = pack8(x0, x1);
                    ss += (x0[0] * x0[0] + x0[1] * x0[1]) + (x0[2] * x0[2] + x0[3] * x0[3]) + (x1[0] * x1[0] + x1[1] * x1[1]) + (x1[2] * x1[2] + x1[3] * x1[3]); }
                { const int ln = fq * 16 + fr; ss += shflx(ss, 16, ln); ss += shflx(ss, 32, ln); }
                if (fq == 0) atomicAdd(rs_out + row, (u64_t)(ss * RS_SCALE)); }
    }
};
struct EpiInproj {
    int row0; int rs_b; int layer;
    __device__ __forceinline__ void operator()(const Acc& acc, const Unit& u, int wr, int wc, int fr, int fq) const {
        KARGS(); bf16_t* P = WSP(bf16_t, WS_P); bf16_t* UG = WSP(bf16_t, WS_UG); float* DT = WSP(float, WS_DT); const u64_t* rs = WSP(u64_t, WS_RS) + (size_t)rs_b * T_ALL + row0;
        const float* ropec = WSP(float, WS_ROPE); const float* ropes = ropec + SEQ * 32; const float* bgate = ap->in[7] + layer * 3072;
        const int pn = u.pn; const int rowb = u.pm * 256 + wr * 64 + fr; const int cl = wc * 32 + 8 * fq;
#pragma unroll
        for (int ai = 0; ai < 2; ++ai)
#pragma unroll
            for (int m = 0; m < 4; ++m) { const int row = rowb + ai * 128 + m * 16; const float rstd = rsqrtf((float)rs[row] * (RS_INV / DM) + EPS);
#pragma unroll
                for (int bj = 0; bj < 2; ++bj) {
                    f32x4 v0 = acc[ai][bj][m][0] * rstd, v1 = acc[ai][bj][m][1] * rstd; const int col = pn * 256 + bj * 128 + cl;
                    if (pn <= 4 || (pn >= 11 && pn <= 14)) { *(u32x4*)(P + (size_t)row * NP + col) = pack8(v0, v1); }
                    else if (pn <= 6) { const int j0 = (pn - 5) * 256 + bj * 128 + cl;
                        if (j0 < 384) { const int g = j0 >> 4, c = j0 & 15; *(u32x4*)(UG + ((size_t)(g * 1024 + (row >> 4)) * 512) + (row & 15) * 16 + c) = pack8(v0, v1); }
                        else if (j0 < 400) { *(f32x4*)(DT + (size_t)row * 16 + (j0 - 384)) = v0; *(f32x4*)(DT + (size_t)row * 16 + (j0 - 384) + 4) = v1; } }
                    else if (pn <= 10) { const int gi = ((bj * 128 + cl) & 63) >> 3; const int pos = row & (SEQ - 1);
                        const f32x4 c = *(const f32x4*)(ropec + pos * 32 + gi * 4), s = *(const f32x4*)(ropes + pos * 32 + gi * 4);
                        f32x4 o0 = v0 * c - v1 * s, o1 = v0 * s + v1 * c; if (pn >= 9) { o0 = o0 * 0.125f; o1 = o1 * 0.125f; }
                        *(u32x4*)(P + (size_t)row * NP + col) = pack8(o0, o1); }
                    else { const int gidx = (pn - 15) * 256 + bj * 128 + cl; f32x4 b0, b1;
#pragma unroll
                        for (int i_ = 0; i_ < 4; ++i_) { b0[i_] = bgate[gidx + i_]; b1[i_] = bgate[gidx + 4 + i_]; }
#pragma unroll
                        for (int i = 0; i < 4; ++i) { v0[i] = sigmoidf_(v0[i] + b0[i]); v1[i] = sigmoidf_(v1[i] + b1[i]); }
                        *(u32x4*)(P + (size_t)row * NP + col) = pack8(v0, v1); } } }
    }
};
struct EpiS5S {
    int dummy;
    __device__ __forceinline__ void operator()(const Acc& acc, const Unit& u, int wr, int wc, int fr, int fq) const {
        KARGS(); float* SC = WSP(float, WS_SC);
        const int rowb = u.pm * 256 + wr * 64 + fr; const int cl = wc * 32 + 8 * fq;
#pragma unroll
        for (int ai = 0; ai < 2; ++ai)
#pragma unroll
            for (int m = 0; m < 4; ++m) { const int row = rowb + ai * 128 + m * 16;
#pragma unroll
                for (int bj = 0; bj < 2; ++bj) { float* o = SC + (size_t)row * 256 + bj * 128 + cl; *(f32x4*)o = acc[ai][bj][m][0]; *(f32x4*)(o + 4) = acc[ai][bj][m][1]; } }
    }
};
struct EpiS5Y {
    int dummy;
    __device__ __forceinline__ void operator()(const Acc& acc, const Unit& u, int wr, int wc, int fr, int fq) const {
        KARGS(); bf16_t* P = WSP(bf16_t, WS_P);
        const int rowb = u.pm * 256 + wr * 64 + fr; const int cl = wc * 32 + 8 * fq;
#pragma unroll
        for (int ai = 0; ai < 2; ++ai)
#pragma unroll
            for (int m = 0; m < 4; ++m) { const int R = rowb + ai * 128 + m * 16; const int g = R >> 10, chunk = R & 1023;
#pragma unroll
                for (int bj = 0; bj < 2; ++bj) { const int c0 = bj * 128 + cl; const int t = c0 >> 4, c = c0 & 15; f32x4 v0 = acc[ai][bj][m][0], v1 = acc[ai][bj][m][1];
#pragma unroll
                    for (int i = 0; i < 4; ++i) { v0[i] = gelu_tanh(v0[i]); v1[i] = gelu_tanh(v1[i]); }
                    *(u32x4*)(P + (size_t)(chunk * 16 + t) * NP + PC_YBP + g * 16 + c) = pack8(v0, v1); } }
    }
};
struct EpiGLU {
    int dummy;
    __device__ __forceinline__ void operator()(const Acc& acc, const Unit& u, int wr, int wc, int fr, int fq) const {
        KARGS(); bf16_t* YB = WSP(bf16_t, WS_YB);
        const int rowb = u.pm * 256 + wr * 64 + fr; const int hc = u.pn * 128 + wc * 32 + fq * 8;
#pragma unroll
        for (int ai = 0; ai < 2; ++ai)
#pragma unroll
            for (int m = 0; m < 4; ++m) { const int row = rowb + ai * 128 + m * 16; f32x4 h0, h1;
#pragma unroll
                for (int i = 0; i < 4; ++i) { h0[i] = acc[ai][0][m][0][i] * sigmoidf_(acc[ai][1][m][0][i]); h1[i] = acc[ai][0][m][1][i] * sigmoidf_(acc[ai][1][m][1][i]); }
                *(u32x4*)(YB + (size_t)row * 384 + hc) = pack8(h0, h1); }
    }
};
struct EpiBr {
    int gcol; int rss_row; int first;
    __device__ __forceinline__ void operator()(const Acc& acc, const Unit& u, int wr, int wc, int fr, int fq) const {
        KARGS(); bf16_t* MIX = WSP(bf16_t, WS_MIX); const bf16_t* P = WSP(bf16_t, WS_P); const u64_t* rss = (rss_row >= 0) ? (WSP(u64_t, WS_RS) + rss_row) : nullptr;
        const int rowb = u.pm * 256 + wr * 64 + fr; const int cl = u.pn * 256 + wc * 32 + 8 * fq;
#pragma unroll
        for (int ai = 0; ai < 2; ++ai)
#pragma unroll
            for (int m = 0; m < 4; ++m) { const int row = rowb + ai * 128 + m * 16; const float sc = rss ? rsqrtf((float)rss[row] * (RS_INV / 512.0f) + EPS) : 1.0f;
#pragma unroll
                for (int bj = 0; bj < 2; ++bj) { const int col = cl + bj * 128;
                    const f32x8 gt = unpack8(*(const u32x4*)(P + (size_t)row * NP + gcol + col));
                    f32x4 a0 = acc[ai][bj][m][0] * sc, a1 = acc[ai][bj][m][1] * sc;
#pragma unroll
                    for (int i = 0; i < 4; ++i) { a0[i] *= gt[i]; a1[i] *= gt[4 + i]; }
                    if (!first) { const f32x8 pv = unpack8(*(const u32x4*)(MIX + (size_t)row * DM + col));
#pragma unroll
                        for (int i = 0; i < 4; ++i) { a0[i] += pv[i]; a1[i] += pv[4 + i]; } }
                    *(u32x4*)(MIX + (size_t)row * DM + col) = pack8(a0, a1); } }
    }
};

struct TrSrc { int ld; int N; int mode; };
__device__ __forceinline__ const float* tr_col(const TrSrc& s, const float* W, const float* W2, int n) {
    if (s.mode == 0) return W + n;
    if (s.mode == 1) { const int j = (n >> 8) * 128 + (n & 127); const long d = ((n >> 7) & 1) ? (long)(W2 - W) : 0l; return W + d + j; }
    int src;
    if (n < 1280) src = n;
    else if (n < 1792) { const int j = n - 1280; if (j < 384) src = 1296 + j; else if (j < 400) src = 1280 + (j - 384); else return nullptr; }
    else if (n < 2816) { int hc = n - 1792; const int isk = hc >= 512; hc &= 511; const int hh = hc >> 6, c = hc & 63; const int d = 4 * (c >> 3) + (c & 3) + 32 * ((c >> 2) & 1); src = (isk ? 2192 : 1680) + hh * 64 + d; }
    else if (n < 3328) src = 2704 + (n - 2816);
    else if (n < 3840) src = 3216 + (n - 3328);
    else src = 3728 + (n - 3840);
    return W + src;
}
__device__ __forceinline__ void tr_item(const float* W, const float* W2, const float* gain, const TrSrc s, int K, bf16_t* WT, LAS float* scr, int item, int lane) {
    const int nblk = s.N / 32, kb = item / nblk, nb = item % nblk, k0 = 64 * kb, n0 = 32 * nb;
    const float* col = tr_col(s, W, W2, n0 + (lane & 31));
    float tv[32];
#pragma unroll
    for (int i = 0; i < 32; ++i) { const int kk = 2 * i + (lane >> 5); tv[i] = col ? col[(size_t)(k0 + kk) * s.ld] : 0.f; }
#pragma unroll
    for (int i = 0; i < 32; ++i) { const int kk = 2 * i + (lane >> 5); float v = tv[i]; if (gain) v *= gain[k0 + kk]; scr[kk * 33 + (lane & 31)] = v; }
    asm volatile("s_waitcnt lgkmcnt(0)" ::: "memory");
    const int c = lane & 7;
#pragma unroll
    for (int j = 0; j < 4; ++j) { const int n = (lane >> 3) + 8 * j; const LAS float* sp = scr + (8 * c) * 33 + n;
        u32x4 o; o.x = cvt_pk_bf16(sp[0 * 33], sp[1 * 33]); o.y = cvt_pk_bf16(sp[2 * 33], sp[3 * 33]); o.z = cvt_pk_bf16(sp[4 * 33], sp[5 * 33]); o.w = cvt_pk_bf16(sp[6 * 33], sp[7 * 33]);
        *(u32x4*)(WT + (size_t)(n0 + n) * K + k0 + 8 * c) = o; }
    asm volatile("s_waitcnt lgkmcnt(0)" ::: "memory");
}

struct S5P { const float *lre, *lim, *lstep, *bre, *bim, *cre, *cim, *d; };
__device__ __forceinline__ void s5_lam(const S5P& p, int dir, int g, int pp, float& lre, float& lim, float& step) {
    lre = fminf(p.lre[(dir * 24 + g) * 64 + pp], -1e-4f); lim = p.lim[(dir * 24 + g) * 64 + pp]; step = __expf(p.lstep[dir * 24 + g]);
}
__device__ __forceinline__ void cpowf_(float lre, float lim, float step, float tau, float& re, float& im) {
    const float mag = __expf(lre * step * tau); const float ang = lim * step * tau; float s, c; sincos_rev(ang * 0.15915494309189535f, s, c); re = mag * c; im = mag * s;
}
__device__ __forceinline__ void s5_coef(float lre, float lim, float step, float& cr, float& ci) {
    float lbr, lbi; cpowf_(lre, lim, step, 1.0f, lbr, lbi); const float nr = lbr - 1.0f, den = lre * lre + lim * lim;
    const float rd = rcpf_(den); cr = (nr * lre + lbi * lim) * rd; ci = (lbi * lre - nr * lim) * rd;
}

struct LaCtx { const bf16_t* P; const float* DT; bf16_t* ST; float* DEC; bf16_t* YA; bf16_t* YC; u64_t* rss; const float* conv_w; const float* conv_b; const float* dt_bias; const float* a_log; const float* dskip; };
constexpr int LA_F32 = 107520;
__device__ __forceinline__ f32x8 la_fetch8(LAS unsigned char* lds, const LaCtx& c, int m, int kind, int h, int row, int c8) {
    if (m == 1) { const int col = (kind == 0 ? PC_V : (kind == 1 ? PC_K : PC_Q)) + h * 64 + c8; return unpack8(*(const u32x4*)(c.P + (size_t)row * NP + col)); }
    const int ch = (kind == 0) ? (h * 64 + c8) : ((kind == 1 ? 512 : 640) + (h >> 2) * 64 + c8);
    const int pos = row & (SEQ - 1);
    const LAS float* cwl = (const LAS float*)(lds + LA_F32 + 4096) + ch;
    f32x8 a; { const f32x4 t0 = *(const LAS f32x4*)(cwl + 3840), t1 = *(const LAS f32x4*)(cwl + 3844); a[0] = t0[0]; a[1] = t0[1]; a[2] = t0[2]; a[3] = t0[3]; a[4] = t1[0]; a[5] = t1[1]; a[6] = t1[2]; a[7] = t1[3]; }
#pragma unroll
    for (int j = 0; j < 5; ++j) { const int pp = pos + j - 2;
        if ((unsigned)pp < (unsigned)SEQ) { const f32x8 v = unpack8(*(const u32x4*)(c.P + (size_t)(row + j - 2) * NP + PC_XBC + ch));
            const f32x4 w0 = *(const LAS f32x4*)(cwl + j * 768), w1 = *(const LAS f32x4*)(cwl + j * 768 + 4);
#pragma unroll
            for (int e = 0; e < 4; ++e) { a[e] += w0[e] * v[e]; a[4 + e] += w1[e] * v[4 + e]; } } }
#pragma unroll
    for (int e = 0; e < 8; ++e) a[e] = siluf_(a[e]);
    return a;
}
__device__ __forceinline__ void la_stage_conv_all(LAS unsigned char* lds, const LaCtx& c, int tid) {
    LAS float* cwl = (LAS float*)(lds + LA_F32 + 4096);
    for (int i = tid; i < 4608; i += 512) cwl[i] = (i < 3840) ? c.conv_w[i] : c.conv_b[i - 3840];
    __syncthreads();
}
__device__ __forceinline__ void la_cs(LAS unsigned char* lds, const LaCtx& c, int m, int h, int rowbase, int wave, int lane) {
    LAS float* cs0 = (LAS float*)(lds + LA_F32); LAS float* ce1 = cs0 + 128; LAS float* dtf = ce1 + 132; LAS float* dtb = dtf + 128; LAS float* dg = dtb + 128;
    if (wave >= 2) return;
    const int t0 = 2 * lane; float d0a = 1.f, d0b = 1.f, d1a = 1.f, d1b = 1.f, x0, x1, dga = 1.f, dgb = 1.f;
    if (m == 0) {
        d0a = softplusf_(c.DT[(size_t)(rowbase + t0) * 16 + h] + c.dt_bias[h]); d0b = softplusf_(c.DT[(size_t)(rowbase + t0 + 1) * 16 + h] + c.dt_bias[h]);
        d1a = softplusf_(c.DT[(size_t)(rowbase + t0) * 16 + 8 + h] + c.dt_bias[8 + h]); d1b = softplusf_(c.DT[(size_t)(rowbase + t0 + 1) * 16 + 8 + h] + c.dt_bias[8 + h]);
        const float A = -__expf(c.a_log[wave * 8 + h]);
        x0 = (wave == 0 ? d0a : d1a) * A; x1 = (wave == 0 ? d0b : d1b) * A;
        dga = d0a + d1a; dgb = d0b + d1b;
    } else { const float e_ = __builtin_amdgcn_ldexpf(1.0f, -5 - h); const float lg = -(e_ + e_ * e_ * (0.5f + e_ * (0.33333334f + 0.25f * e_))); x0 = lg; x1 = lg; }
    const float pair = x0 + x1; float inc = pair;
#pragma unroll
    for (int off = 1; off < 64; off <<= 1) { const float v = __builtin_bit_cast(float, __builtin_amdgcn_ds_bpermute((lane - off) << 2, __builtin_bit_cast(int, inc))); if (lane >= off) inc += v; }
    const float exc = inc - pair;
    if (wave == 0) { cs0[t0] = exc + x0; cs0[t0 + 1] = inc; dtf[t0] = d0a; dtf[t0 + 1] = d0b; dg[t0] = dga; dg[t0 + 1] = dgb; }
    else { ce1[t0] = exc; ce1[t0 + 1] = exc + x0; if (lane == 63) ce1[128] = inc; dtb[t0] = d1a; dtb[t0 + 1] = d1b; }
}
#define MFMA16(a, b, c) __builtin_amdgcn_mfma_f32_16x16x32_bf16(a, b, c, 0, 0, 0)
__device__ __forceinline__ int tsw(int row, int s) { return (((s >> 3) ^ ((row >> 3) & 7)) << 3) | (s & 7); }
__device__ __forceinline__ void la_unit_A(LAS unsigned char* lds, const LaCtx c, int m, int bb, int ci, int h, int tid) {
    const int wave = __builtin_amdgcn_readfirstlane(tid >> 6), lane = tid & 63;
    LAS float* cs0 = (LAS float*)(lds + LA_F32); LAS float* ce1 = cs0 + 128; LAS float* dtf = ce1 + 132; LAS float* dtb = dtf + 128;
    const int rowbase = bb * SEQ + ci * 128;
    la_cs(lds, c, m, h, rowbase, wave, lane);
    __syncthreads();
    const float csl = cs0[127];
#pragma unroll
    for (int it = 0; it < 2; ++it) { const int idx = tid + it * 512; const int s = idx >> 3, c8 = (idx & 7) * 8;
        const f32x8 x = la_fetch8(lds, c, m, 0, h, rowbase + s, c8), b = la_fetch8(lds, c, m, 1, h, rowbase + s, c8);
        const float wf = __expf(csl - cs0[s]) * dtf[s], wb = __expf(ce1[s]) * dtb[s];
        const int sw = tsw(c8, s);
        LAS bf16_t* xt = (LAS bf16_t*)(lds) + c8 * 136 + sw; LAS bf16_t* bf = (LAS bf16_t*)(lds + 17408) + c8 * 136 + sw; LAS bf16_t* bk = (LAS bf16_t*)(lds + 34816) + c8 * 136 + sw;
#pragma unroll
        for (int e = 0; e < 8; ++e) { xt[e * 136] = (bf16_t)f2bf(x[e]); bf[e * 136] = (bf16_t)f2bf(b[e] * wf); bk[e * 136] = (bf16_t)f2bf(b[e] * wb); } }
    if (tid < 2) c.DEC[((((m * 2 + bb) * 8 + h) * 2 + tid) * 64) + ci] = (tid == 0) ? __expf(csl) : __expf(ce1[128]);
    __syncthreads();
    const int dir = wave >> 2, nb = wave & 3, q = lane >> 4, r16 = lane & 15;
    LAS unsigned char* Bt = lds + 17408 + dir * 17408;
    bf16x8 af[4];
#pragma unroll
    for (int ks = 0; ks < 4; ++ks) af[ks] = *(const LAS bf16x8*)(Bt + ((16 * nb + r16) * 136 + tsw(16 * nb + r16, 32 * ks + 8 * q)) * 2);
    bf16_t* stb = c.ST + ((size_t)((((m * 2 + bb) * 8 + h) * 2 + dir) * 64 + ci)) * 4096;
#pragma unroll
    for (int pb = 0; pb < 4; ++pb) { f32x4 acc = (f32x4){0.f, 0.f, 0.f, 0.f};
#pragma unroll
        for (int ks = 0; ks < 4; ++ks) { const bf16x8 bfr = *(const LAS bf16x8*)(lds + ((16 * pb + r16) * 136 + tsw(16 * pb + r16, 32 * ks + 8 * q)) * 2); acc = MFMA16(af[ks], bfr, acc); }
        u32x2 w; w.x = cvt_pk_bf16(acc[0], acc[1]); w.y = cvt_pk_bf16(acc[2], acc[3]);
        *(u32x2*)(stb + (16 * pb + r16) * 64 + 16 * nb + 4 * q) = w; }
    __syncthreads();
}
__device__ __forceinline__ void la_unit_C(LAS unsigned char* lds, const LaCtx c, int m, int bb, int ci, int h, int tid, int grow0) {
    const int wave = __builtin_amdgcn_readfirstlane(tid >> 6), lane = tid & 63;
    LAS float* cs0 = (LAS float*)(lds + LA_F32); LAS float* ce1 = cs0 + 128; LAS float* dtf = ce1 + 132; LAS float* dtb = dtf + 128; LAS float* dg = dtb + 128;
    constexpr int O_CQ = 0, O_BK = 18432, O_XT = 36864, O_P = 54272, O_SF = 89088, O_SB = 98304;
    const int rowbase = bb * SEQ + ci * 128;
    la_cs(lds, c, m, h, rowbase, wave, lane);
#pragma unroll
    for (int it = 0; it < 2; ++it) { const int idx = tid + it * 512; const int s = idx >> 3, c8 = (idx & 7) * 8;
        const f32x8 x = la_fetch8(lds, c, m, 0, h, rowbase + s, c8), b = la_fetch8(lds, c, m, 1, h, rowbase + s, c8), qv = la_fetch8(lds, c, m, 2, h, rowbase + s, c8);
        u32x4 wq, wb;
        wq.x = cvt_pk_bf16(qv[0], qv[1]); wq.y = cvt_pk_bf16(qv[2], qv[3]); wq.z = cvt_pk_bf16(qv[4], qv[5]); wq.w = cvt_pk_bf16(qv[6], qv[7]);
        wb.x = cvt_pk_bf16(b[0], b[1]); wb.y = cvt_pk_bf16(b[2], b[3]); wb.z = cvt_pk_bf16(b[4], b[5]); wb.w = cvt_pk_bf16(b[6], b[7]);
        *(LAS u32x4*)(lds + O_CQ + (s * 72 + c8) * 2) = wq; *(LAS u32x4*)(lds + O_BK + (s * 72 + c8) * 2) = wb;
        LAS bf16_t* xt = (LAS bf16_t*)(lds + O_XT) + c8 * 136 + tsw(c8, s);
#pragma unroll
        for (int e = 0; e < 8; ++e) xt[e * 136] = (bf16_t)f2bf(x[e]); }
    { const bf16_t* sf = c.ST + ((size_t)((((m * 2 + bb) * 8 + h) * 2 + 0) * 64 + ci)) * 4096 + tid * 8; const bf16_t* sb = sf + (size_t)64 * 4096;
      const int p = tid >> 3, n8 = (tid & 7) * 8;
      *(LAS u32x4*)(lds + O_SF + (p * 72 + n8) * 2) = *(const u32x4*)sf; *(LAS u32x4*)(lds + O_SB + (p * 72 + n8) * 2) = *(const u32x4*)sb; }
    __syncthreads();
    const int q = lane >> 4, r16 = lane & 15; const int t = 16 * wave + r16;
    u32x2 zg[4];
#pragma unroll
    for (int pb = 0; pb < 4; ++pb) zg[pb] = *(const u32x2*)(c.P + (size_t)(rowbase + t) * NP + (m == 0 ? PC_Z : PC_G) + h * 64 + 16 * pb + 4 * q);
    bf16x8 bq[2];
#pragma unroll
    for (int ks = 0; ks < 2; ++ks) bq[ks] = *(const LAS bf16x8*)(lds + O_CQ + (t * 72 + 32 * ks + 8 * q) * 2);
    const float cs0_t = cs0[t], ce1_t = ce1[t], dg_t = dg[t];
#pragma unroll
    for (int sb = 0; sb < 8; ++sb) { f32x4 acc = (f32x4){0.f, 0.f, 0.f, 0.f};
#pragma unroll
        for (int ks = 0; ks < 2; ++ks) { const bf16x8 a = *(const LAS bf16x8*)(lds + O_BK + ((16 * sb + r16) * 72 + 32 * ks + 8 * q) * 2); acc = MFMA16(a, bq[ks], acc); }
        const int s0 = 16 * sb + 4 * q;
        const f32x4 c0 = *(const LAS f32x4*)(cs0 + s0), e1 = *(const LAS f32x4*)(ce1 + s0), df = *(const LAS f32x4*)(dtf + s0), db = *(const LAS f32x4*)(dtb + s0);
        float pv[4];
#pragma unroll
        for (int r = 0; r < 4; ++r) { const int s = s0 + r; const float arg = (s < t) ? (cs0_t - c0[r]) : (e1[r] - ce1_t);
            float w = __expf(arg) * ((s < t) ? df[r] : db[r]); if (s == t) w = dg_t; pv[r] = acc[r] * w; }
        u32x2 w2; w2.x = cvt_pk_bf16(pv[0], pv[1]); w2.y = cvt_pk_bf16(pv[2], pv[3]);
        *(LAS u32x2*)(lds + O_P + (t * 136 + s0) * 2) = w2; }
    __syncthreads();
    f32x4 aY[4], aF[4], aB[4];
#pragma unroll
    for (int pb = 0; pb < 4; ++pb) { aY[pb] = (f32x4){0.f, 0.f, 0.f, 0.f}; aF[pb] = aY[pb]; aB[pb] = aY[pb]; }
#pragma unroll
    for (int ks = 0; ks < 4; ++ks) { const bf16x8 bp = *(const LAS bf16x8*)(lds + O_P + (t * 136 + 32 * ks + 8 * q) * 2);
#pragma unroll
        for (int pb = 0; pb < 4; ++pb) { const bf16x8 a = *(const LAS bf16x8*)(lds + O_XT + ((16 * pb + r16) * 136 + tsw(16 * pb + r16, 32 * ks + 8 * q)) * 2); aY[pb] = MFMA16(a, bp, aY[pb]); } }
#pragma unroll
    for (int ks = 0; ks < 2; ++ks)
#pragma unroll
        for (int pb = 0; pb < 4; ++pb) { const bf16x8 a = *(const LAS bf16x8*)(lds + O_SF + ((16 * pb + r16) * 72 + 32 * ks + 8 * q) * 2); aF[pb] = MFMA16(a, bq[ks], aF[pb]);
            const bf16x8 a2 = *(const LAS bf16x8*)(lds + O_SB + ((16 * pb + r16) * 72 + 32 * ks + 8 * q) * 2); aB[pb] = MFMA16(a2, bq[ks], aB[pb]); }
    const float rf = __expf(cs0_t), rb = __expf(ce1[128] - ce1_t);
    const int row = rowbase + t;
    float ss = 0.f; f32x4 y[4];
#pragma unroll
    for (int pb = 0; pb < 4; ++pb) { y[pb] = aY[pb] + rf * aF[pb] + rb * aB[pb]; }
    if (m == 0) {
        const float dsk = c.dskip[h];
#pragma unroll
        for (int pb = 0; pb < 4; ++pb)
#pragma unroll
            for (int r = 0; r < 4; ++r) { const unsigned xv = *((const LAS bf16_t*)(lds + O_XT) + (16 * pb + 4 * q + r) * 136 + tsw(16 * pb + 4 * q + r, t)); y[pb][r] += dsk * __builtin_bit_cast(float, xv << 16); }
#pragma unroll
        for (int pb = 0; pb < 4; ++pb) { const int col = h * 64 + 16 * pb + 4 * q; const u32x2 zz = zg[pb];
            f32x4 o; o[0] = y[pb][0] * siluf_(bflo(zz.x)); o[1] = y[pb][1] * siluf_(bfhi(zz.x)); o[2] = y[pb][2] * siluf_(bflo(zz.y)); o[3] = y[pb][3] * siluf_(bfhi(zz.y));
            ss += (o[0] * o[0] + o[1] * o[1]) + (o[2] * o[2] + o[3] * o[3]);
            u32x2 w; w.x = cvt_pk_bf16(o[0], o[1]); w.y = cvt_pk_bf16(o[2], o[3]); *(u32x2*)(c.YA + (size_t)row * 512 + col) = w; }
        ss += shflx(ss, 16, lane); ss += shflx(ss, 32, lane);
        if (q == 0) atomicAdd(c.rss + grow0 + row, (u64_t)(ss * RS_SCALE));
    } else {
#pragma unroll
        for (int pb = 0; pb < 4; ++pb) ss += (y[pb][0] * y[pb][0] + y[pb][1] * y[pb][1]) + (y[pb][2] * y[pb][2] + y[pb][3] * y[pb][3]);
        ss += shflx(ss, 16, lane); ss += shflx(ss, 32, lane);
        const float rstd = rsqrtf(ss * (1.0f / 64.0f) + EPS);
#pragma unroll
        for (int pb = 0; pb < 4; ++pb) { const int col = h * 64 + 16 * pb + 4 * q; const u32x2 gg = zg[pb];
            f32x4 o; o[0] = y[pb][0] * rstd * siluf_(bflo(gg.x)); o[1] = y[pb][1] * rstd * siluf_(bfhi(gg.x)); o[2] = y[pb][2] * rstd * siluf_(bflo(gg.y)); o[3] = y[pb][3] * rstd * siluf_(bfhi(gg.y));
            u32x2 w; w.x = cvt_pk_bf16(o[0], o[1]); w.y = cvt_pk_bf16(o[2], o[3]); *(u32x2*)(c.YC + (size_t)row * 512 + col) = w; }
    }
    __syncthreads();
}
__device__ __forceinline__ void la_scan_item(const LaCtx c, int item, int tid) {
    const int quarter = item & 3, seq = item >> 2;
    const int dir = seq & 1;
    unsigned* base = (unsigned*)(c.ST + (size_t)seq * 64 * 4096 + quarter * 1024) + tid;
    const float* dec = c.DEC + seq * 64;
    float s0 = 0.f, s1 = 0.f;
#pragma unroll 1
    for (int b = 0; b < 2; ++b) {
        unsigned r[32];
#pragma unroll
        for (int k = 0; k < 32; ++k) { const int o = b * 32 + k; const int ci = dir ? (63 - o) : o; r[k] = base[(size_t)ci * 2048]; }
#pragma unroll
        for (int k = 0; k < 32; ++k) { const int o = b * 32 + k; const int ci = dir ? (63 - o) : o; const float lo = bflo(r[k]), hi = bfhi(r[k]);
            base[(size_t)ci * 2048] = cvt_pk_bf16(s0, s1); const float d = dec[ci]; s0 = d * s0 + lo; s1 = d * s1 + hi; }
    }
}
__device__ __forceinline__ void s5_scan_item(LAS unsigned char* lds, const S5P p, const float* SC, bf16_t* UG, int item, int tid) {
    const int wave = __builtin_amdgcn_readfirstlane(tid >> 6), lane = tid & 63;
    const int dir = item & 1, g = (item >> 1) % 24, bb = item / 48;
    float lre, lim, step; s5_lam(p, dir, g, lane, lre, lim, step);
    float Lr, Li, Sr, Si; cpowf_(lre, lim, step, 16.0f, Lr, Li); cpowf_(lre, lim, step, 1024.0f, Sr, Si);
    const size_t rbase = (size_t)g * 1024 + bb * 512;
    float hr = 0.f, hi = 0.f;
#pragma unroll 1
    for (int b = 0; b < 4; ++b) {
        float re[16], im[16];
#pragma unroll
        for (int k = 0; k < 16; ++k) { const int o = wave * 64 + b * 16 + k; const int ci = dir ? (511 - o) : o; const size_t row = rbase + ci;
            re[k] = SC[row * 256 + dir * 128 + lane]; im[k] = SC[row * 256 + dir * 128 + 64 + lane]; }
#pragma unroll
        for (int k = 0; k < 16; ++k) { const float nr = Lr * hr - Li * hi + re[k], ni = Lr * hi + Li * hr + im[k]; hr = nr; hi = ni; }
    }
    LAS float* totr = (LAS float*)lds; LAS float* toti = totr + 512;
    totr[wave * 64 + lane] = hr; toti[wave * 64 + lane] = hi;
    __syncthreads();
    float Hr = 0.f, Hi = 0.f;
#pragma unroll
    for (int j = 0; j < 7; ++j) if (j < wave) { const float tr = totr[j * 64 + lane], ti = toti[j * 64 + lane]; const float nr = Sr * Hr - Si * Hi + tr, ni = Sr * Hi + Si * Hr + ti; Hr = nr; Hi = ni; }
#pragma unroll 1
    for (int b = 0; b < 4; ++b) {
        float re[16], im[16];
#pragma unroll
        for (int k = 0; k < 16; ++k) { const int o = wave * 64 + b * 16 + k; const int ci = dir ? (511 - o) : o; const size_t row = rbase + ci;
            re[k] = SC[row * 256 + dir * 128 + lane]; im[k] = SC[row * 256 + dir * 128 + 64 + lane]; }
#pragma unroll
        for (int k = 0; k < 16; ++k) { const int o = wave * 64 + b * 16 + k; const int ci = dir ? (511 - o) : o; const size_t row = rbase + ci;
            UG[row * 512 + 256 + dir * 128 + lane] = (bf16_t)f2bf(Hr); UG[row * 512 + 256 + dir * 128 + 64 + lane] = (bf16_t)f2bf(Hi);
            const float nr = Lr * Hr - Li * Hi + re[k], ni = Lr * Hi + Li * Hr + im[k]; Hr = nr; Hi = ni; }
    }
    __syncthreads();
}


constexpr size_t WS_BAR = 1 * MiB;
#define XB_TMO      128
#define XB_XCNT(j)  (256  + 64 * (j))
#define XB_XSUB(j)  (1280 + 64 * (j))
#define XB_XGEN(j)  (2304 + 64 * (j))
#define XB_TOP      3328
#define XB_TOPGEN   3392
#define XCD_BAR_WORDS 3456
#define XB_SPIN_CAP (1u << 22)
__device__ __forceinline__ unsigned xb_ld(unsigned* p)              { return __hip_atomic_load(p, __ATOMIC_RELAXED, __HIP_MEMORY_SCOPE_AGENT); }
__device__ __forceinline__ unsigned xb_add(unsigned* p, unsigned v) { return __hip_atomic_fetch_add(p, v, __ATOMIC_RELAXED, __HIP_MEMORY_SCOPE_AGENT); }
__device__ __forceinline__ unsigned xb_xcc_id() { return (unsigned)__builtin_amdgcn_s_getreg((3 << 11) | 20) & 0xFu; }
#define XB_SPIN(cond, bar) do { unsigned _sp = 0; while (cond) { __builtin_amdgcn_s_sleep(1); \
    if ((++_sp & 255u) == 0u) { if (xb_ld(&(bar)[XB_TMO])) break; if (_sp > XB_SPIN_CAP) { atomicAdd(&(bar)[XB_TMO], 1u); break; } } } } while (0)
__device__ __forceinline__ void xcd_barrier_complete(unsigned* bar, unsigned x, unsigned G, unsigned& nloc, unsigned& nx) {
    unsigned sum, cnt, mine, sp = 0u;
    for (;;) {
        sum = 0u; cnt = 0u; mine = 0u;
#pragma unroll
        for (unsigned j = 0; j < 16; ++j) { const unsigned c = xb_ld(&bar[XB_XCNT(j)]); sum += c; cnt += (c > 0u) ? 1u : 0u; mine = (j == x) ? c : mine; }
        if (sum == G) break;
        __builtin_amdgcn_s_sleep(1);
        if ((++sp & 255u) == 0u) { if (xb_ld(&bar[XB_TMO])) break; if (sp > XB_SPIN_CAP) { atomicAdd(&bar[XB_TMO], 1u); break; } }
    }
    nloc = mine > 0u ? mine : 1u; nx = cnt > 0u ? cnt : 1u;
}
__device__ __forceinline__ void xcd_barrier(unsigned* bar, volatile LAS unsigned* st, bool t0, unsigned G) {
    asm volatile("s_waitcnt vmcnt(0)" ::: "memory");
    __syncthreads();
    if (t0) {
        const unsigned x = xb_xcc_id();
        __builtin_amdgcn_s_waitcnt(0);
        unsigned nloc = st[0], nx = st[1];
        if (nloc == 0u) { xcd_barrier_complete(bar, x, G, nloc, nx); st[0] = nloc; st[1] = nx; }
        const unsigned old = xb_add(&bar[XB_XSUB(x)], 1u);
        const unsigned gen = old / nloc;
        if (old + 1u == (gen + 1u) * nloc) {
            __builtin_amdgcn_fence(__ATOMIC_RELEASE, "agent");
            asm volatile("s_waitcnt vmcnt(0)" ::: "memory");
            const unsigned og = xb_add(&bar[XB_TOP], 1u);
            const unsigned tg = og / nx;
            if (og + 1u == (tg + 1u) * nx) xb_add(&bar[XB_TOPGEN], 1u);
            else XB_SPIN(xb_ld(&bar[XB_TOPGEN]) == tg, bar);
            __builtin_amdgcn_fence(__ATOMIC_ACQUIRE, "agent");
            xb_add(&bar[XB_XGEN(x)], 1u);
            asm volatile("s_waitcnt vmcnt(0)" ::: "memory");
        } else {
            XB_SPIN(xb_ld(&bar[XB_XGEN(x)]) == gen, bar);
            __builtin_amdgcn_fence(__ATOMIC_ACQUIRE, "agent");
            asm volatile("s_waitcnt vmcnt(0)" ::: "memory");
        }
    }
    __syncthreads();
}


__device__ __forceinline__ S5P make_s5p(KArgP ap, int layer) {
    S5P sp; sp.lre = ap->in[15] + layer * 3072; sp.lim = ap->in[16] + layer * 3072; sp.lstep = ap->in[17] + layer * 48; sp.bre = ap->in[18] + layer * 24576; sp.bim = ap->in[19] + layer * 24576;
    sp.cre = ap->in[20] + layer * 49152; sp.cim = ap->in[21] + layer * 49152; sp.d = ap->in[22] + layer * 384; return sp;
}
__device__ __forceinline__ LaCtx make_lactx(KArgP ap, unsigned char* ws, int layer) {
    LaCtx lc; lc.P = WSP(bf16_t, WS_P); lc.DT = WSP(float, WS_DT); lc.ST = WSP(bf16_t, WS_ST); lc.DEC = WSP(float, WS_DEC); lc.YA = WSP(bf16_t, WS_YA); lc.YC = WSP(bf16_t, WS_YC);
    lc.rss = WSP(u64_t, WS_RS) + (size_t)(7 + layer) * T_ALL;
    lc.conv_w = ap->in[8] + layer * 5 * 768; lc.conv_b = ap->in[9] + layer * 768; lc.dt_bias = ap->in[10] + layer * 16; lc.a_log = ap->in[11] + layer * 16; lc.dskip = ap->in[12] + layer * 8;
    return lc;
}

__global__ void __launch_bounds__(512, 2) mega_fwd(Args a_unused) {
    extern __shared__ __attribute__((aligned(16))) unsigned char lds_raw[];
    LAS unsigned char* lds0 = (LAS unsigned char*)lds_raw;
    cg::grid_group grid = cg::this_grid();
#define GSYNC() do { PHASE(); TID_LOCAL(); xcd_barrier(WSP(unsigned, WS_BAR), (volatile LAS unsigned*)(lds + 131072 + 512), tid == 0, (unsigned)G); } while (0)
    const int wave0 = __builtin_amdgcn_readfirstlane((int)threadIdx.x >> 6);
    { if (threadIdx.x < 2) ((volatile LAS unsigned*)(lds0 + 131072 + 512))[threadIdx.x] = 0u; __syncthreads();
      KArgP ap0 = (KArgP)__builtin_amdgcn_kernarg_segment_ptr(); unsigned* bar0 = (unsigned*)(ap0->ws + WS_BAR); if (threadIdx.x == 0) (void)xb_add(&bar0[XB_XCNT(xb_xcc_id())], 1u);
      grid.sync(); }

    { PHASE(); TID_LOCAL();
      u64_t* RS = WSP(u64_t, WS_RS); bf16_t* XB = WSP(bf16_t, WS_XB); float* ROPEC = WSP(float, WS_ROPE); float* ROPES = ROPEC + SEQ * 32; const float* xin = ap->in[0];
      for (int m = gw; m < T_ALL; m += 2 * NGW) {
        const int m2 = m + NGW; const bool has2 = m2 < T_ALL;
        const float* xr = xin + (size_t)m * DM + lane; const float* xr2 = xin + (size_t)(has2 ? m2 : m) * DM + lane;
        float va[16], vb[16];
#pragma unroll
        for (int j = 0; j < 16; ++j) { va[j] = xr[64 * j]; vb[j] = xr2[64 * j]; }
        bf16_t* xb = XB + (size_t)m * DM + lane; bf16_t* xb2 = XB + (size_t)m2 * DM + lane; float s = 0.f, s2 = 0.f;
#pragma unroll
        for (int j = 0; j < 16; ++j) { s += va[j] * va[j]; xb[64 * j] = (bf16_t)f2bf(va[j]); s2 += vb[j] * vb[j]; if (has2) xb2[64 * j] = (bf16_t)f2bf(vb[j]); }
        s = wave_sum(s, lane); s2 = wave_sum(s2, lane);
        if (lane == 0) { RS[m] = (u64_t)(s * RS_SCALE); if (has2) RS[m2] = (u64_t)(s2 * RS_SCALE); }
      }
      for (int i = gt; i < 8 * T_ALL; i += NGT) RS[T_ALL + i] = 0ull;
      for (int i = gt; i < SEQ * 32; i += NGT) { const int pos = i >> 5, j = i & 31; double inv = 1.0; for (int q = 0; q < j; ++q) inv *= 0.74989420933245582730; const double rev = (double)pos * inv * 0.15915494309189533577; const float fr_ = (float)(rev - floor(rev)); ROPEC[i] = __builtin_amdgcn_cosf(fr_); ROPES[i] = __builtin_amdgcn_sinf(fr_); }
    }

    for (int layer = 0; layer < 2; ++layer) {
        { PHASE(); TID_LOCAL();
            LAS float* scr = (LAS float*)(lds + wave * 16384);
            constexpr int I_GU = 16 * 176, I_D = 44 * 32, I_IN = 16 * 216, I_A = 8 * 32, I_B = 6 * 32, I_GLU = 6 * 24, I_C = 8 * 32, I_O = 16 * 32;
            constexpr int NITEMS = 2 * I_GU + 2 * I_D + I_IN + I_A + I_B + I_GLU + I_C + I_O;
            for (int it = gw; it < NITEMS; it += NGW) {
                int r = it;
                if (r < I_GU) { TrSrc s{FF, 2 * FF, 1}; tr_item(ap->in[2] + (size_t)layer * DM * FF, ap->in[3] + (size_t)layer * DM * FF, ap->in[1] + layer * DM, s, DM, WSP(bf16_t, WS_WGU1), scr, r, lane); continue; } r -= I_GU;
                if (r < I_GU) { TrSrc s{FF, 2 * FF, 1}; tr_item(ap->in[30] + (size_t)layer * DM * FF, ap->in[31] + (size_t)layer * DM * FF, ap->in[29] + layer * DM, s, DM, WSP(bf16_t, WS_WGU2), scr, r, lane); continue; } r -= I_GU;
                if (r < I_D) { TrSrc s{DM, DM, 0}; tr_item(ap->in[4] + (size_t)layer * DM * FF, nullptr, nullptr, s, FF, WSP(bf16_t, WS_WD1), scr, r, lane); continue; } r -= I_D;
                if (r < I_D) { TrSrc s{DM, DM, 0}; tr_item(ap->in[32] + (size_t)layer * DM * FF, nullptr, nullptr, s, FF, WSP(bf16_t, WS_WD2), scr, r, lane); continue; } r -= I_D;
                if (r < I_IN) { TrSrc s{6800, NP, 2}; tr_item(ap->in[6] + (size_t)layer * DM * 6800, nullptr, ap->in[5] + layer * DM, s, DM, WSP(bf16_t, WS_WIN), scr, r, lane); continue; } r -= I_IN;
                if (r < I_A) { TrSrc s{DM, DM, 0}; tr_item(ap->in[14] + (size_t)layer * 512 * DM, nullptr, ap->in[13] + layer * 512, s, 512, WSP(bf16_t, WS_WA), scr, r, lane); continue; } r -= I_A;
                if (r < I_B) { TrSrc s{DM, DM, 0}; tr_item(ap->in[25] + (size_t)layer * 384 * DM, nullptr, nullptr, s, 384, WSP(bf16_t, WS_WB), scr, r, lane); continue; } r -= I_B;
                if (r < I_GLU) { TrSrc s{384, 768, 1}; tr_item(ap->in[23] + (size_t)layer * 384 * 384, ap->in[24] + (size_t)layer * 384 * 384, nullptr, s, 384, WSP(bf16_t, WS_WGLU), scr, r, lane); continue; } r -= I_GLU;
                if (r < I_C) { TrSrc s{DM, DM, 0}; tr_item(ap->in[27] + (size_t)layer * 512 * DM, nullptr, ap->in[26] + layer * 512, s, 512, WSP(bf16_t, WS_WC), scr, r, lane); continue; } r -= I_C;
                { TrSrc s{DM, DM, 0}; tr_item(ap->in[28] + (size_t)layer * DM * DM, nullptr, nullptr, s, DM, WSP(bf16_t, WS_WOUT), scr, r, lane); }
            }
        }
        { PHASE(); TID_LOCAL(); const S5P sp = make_s5p(ap, layer); float* KTAB = WSP(float, WS_KTAB);
            for (int i = gt; i < 24 * 2 * 16 * 256; i += NGT) {
                const int cc = i & 15, c = (i >> 4) & 15, tau = (i >> 8) & 15, dir = (i >> 12) & 1, g = i >> 13; float sum = 0.f;
                for (int pp = 0; pp < 64; ++pp) { float lre, lim, step; s5_lam(sp, dir, g, pp, lre, lim, step); float cr, ci; s5_coef(lre, lim, step, cr, ci);
                    float pr, pi; cpowf_(lre, lim, step, (float)tau, pr, pi); const float mr = pr * cr - pi * ci, mi = pr * ci + pi * cr;
                    const float br = sp.bre[(g * 64 + pp) * 16 + cc], bi = sp.bim[(g * 64 + pp) * 16 + cc]; const float mbr = mr * br - mi * bi, mbi = mr * bi + mi * br;
                    const float c_r = sp.cre[((dir * 24 + g) * 16 + c) * 64 + pp], c_i = sp.cim[((dir * 24 + g) * 16 + c) * 64 + pp];
                    sum += c_r * mbr - c_i * mbi; }
                KTAB[i] = sum;
            }
        }
        { PHASE(); TID_LOCAL(); const S5P sp = make_s5p(ap, layer); bf16_t* S5S = WSP(bf16_t, WS_S5S); bf16_t* S5Y = WSP(bf16_t, WS_S5Y);
            for (int i = gt; i < 24 * 256 * 256; i += NGT) {
                const int k = i & 255, n = (i >> 8) & 255, g = i >> 16;
                { const int s = k >> 4, cc = k & 15; const int dir = n >> 7, isim = (n >> 6) & 1, pp = n & 63; const float tau = dir == 0 ? (float)(15 - s) : (float)s;
                  float lre, lim, step; s5_lam(sp, dir, g, pp, lre, lim, step); float cr, ci; s5_coef(lre, lim, step, cr, ci); float pr, pi; cpowf_(lre, lim, step, tau, pr, pi);
                  const float mr = pr * cr - pi * ci, mi = pr * ci + pi * cr; const float br = sp.bre[(g * 64 + pp) * 16 + cc], bi = sp.bim[(g * 64 + pp) * 16 + cc];
                  const float val = isim ? (mr * bi + mi * br) : (mr * br - mi * bi); S5S[i] = (bf16_t)f2bf(val); }
                { const int t = n >> 4, c = n & 15; const int dir = k >> 7, isim = (k >> 6) & 1, pp = k & 63; const float tau = dir == 0 ? (float)(t + 1) : (float)(16 - t);
                  float lre, lim, step; s5_lam(sp, dir, g, pp, lre, lim, step); float pr, pi; cpowf_(lre, lim, step, tau, pr, pi);
                  const float c_r = sp.cre[((dir * 24 + g) * 16 + c) * 64 + pp], c_i = sp.cim[((dir * 24 + g) * 16 + c) * 64 + pp];
                  const float val = isim ? -(c_r * pi + c_i * pr) : (c_r * pr - c_i * pi); S5Y[((size_t)(g * 256 + n)) * 512 + 256 + k] = (bf16_t)f2bf(val); }
            }
        }
        GSYNC();
        { PHASE(); TID_LOCAL(); const float* KTAB = WSP(float, WS_KTAB); bf16_t* S5Y = WSP(bf16_t, WS_S5Y); const float* dd = ap->in[22] + layer * 384;
        for (int i = gt; i < 24 * 256 * 256; i += NGT) {
            const int k = i & 255, n = (i >> 8) & 255, g = i >> 16; const int s = k >> 4, cc = k & 15, t = n >> 4, c = n & 15; float v = 0.f;
            if (t >= s) v += KTAB[(((g * 2 + 0) * 16 + (t - s)) * 16 + c) * 16 + cc];
            if (s >= t) v += KTAB[(((g * 2 + 1) * 16 + (s - t)) * 16 + c) * 16 + cc];
            if (s == t && c == cc) v += dd[g * 16 + c];
            S5Y[((size_t)(g * 256 + n)) * 512 + k] = (bf16_t)f2bf(v);
        } }

        for (int f = 0; f < 2; ++f) {
            const int sidx = layer * 2 + f;
            const int rs_in = (sidx == 0) ? 0 : (sidx == 1 ? 2 : (sidx == 2 ? 3 : 5));
            const int rs_out = rs_in + 1;
            { PHASE(); TID_LOCAL(); pg8::Gemm g{WSP(bf16_t, WS_XB), WSP(bf16_t, f ? WS_WGU2 : WS_WGU1), DM, DM, DM}; pg8::SchedFull S; S.init(T_ALL / 256, 2 * FF / 256, G, bid);
              EpiGU E{rs_in}; pg8::gemm_phase(lds, g, S, E, tid); }
            GSYNC();
            { PHASE(); TID_LOCAL(); pg8::Gemm g{WSP(bf16_t, WS_H), WSP(bf16_t, f ? WS_WD2 : WS_WD1), FF, FF, FF}; pg8::SchedFull S; S.init(T_ALL / 256, DM / 256, G, bid);
              EpiRes E{(sidx == 0) ? 1 : 0, 0, rs_out, 0.5f}; pg8::gemm_phase(lds, g, S, E, tid); }
            GSYNC();
            if (f == 1) break;
            const int rs_b = rs_out, rs_c = rs_out + 1;
            for (int half = 0; half < 2; ++half) {
                const int row0 = half * TH;
                { PHASE(); TID_LOCAL(); pg8::Gemm g{WSP(bf16_t, WS_XB) + (size_t)row0 * DM, WSP(bf16_t, WS_WIN), DM, DM, DM}; pg8::SchedFull S; S.init(TH / 256, NP / 256, G, bid);
                  EpiInproj E{row0, rs_b, layer};
                  pg8::gemm_phase(lds, g, S, E, tid); }
                GSYNC();
                { PHASE(); TID_LOCAL(); pg8::Gemm g{WSP(bf16_t, WS_UG), WSP(bf16_t, WS_S5S), 512, 256, 256}; pg8::SchedGrp S; S.init(4, 1, 24, G, bid); EpiS5S E{0}; pg8::gemm_phase(lds, g, S, E, tid); }
                { PHASE(); TID_LOCAL(); const LaCtx lc = make_lactx(ap, ws, layer); la_stage_conv_all(lds, lc, tid);
                  for (int un = bid; un < 2048; un += G) { const int h = un & 7, ci = (un >> 3) & 63, bb = (un >> 9) & 1, m = un >> 10; la_unit_A(lds, lc, m, bb, ci, h, tid); } }
                GSYNC();
                { PHASE(); TID_LOCAL(); const LaCtx lc = make_lactx(ap, ws, layer);
                  for (int it = bid; it < 256; it += G) la_scan_item(lc, it, tid); }
                { PHASE(); TID_LOCAL(); const S5P sp = make_s5p(ap, layer);
                  for (int it = bid; it < 96; it += G) s5_scan_item(lds, sp, WSP(float, WS_SC), WSP(bf16_t, WS_UG), it, tid); }
                GSYNC();
                { PHASE(); TID_LOCAL(); pg8::Gemm g{WSP(bf16_t, WS_UG), WSP(bf16_t, WS_S5Y), 512, 512, 512}; pg8::SchedGrp S; S.init(4, 1, 24, G, bid); EpiS5Y E{0}; pg8::gemm_phase(lds, g, S, E, tid); }
                { PHASE(); TID_LOCAL(); const LaCtx lc = make_lactx(ap, ws, layer); la_stage_conv_all(lds, lc, tid);
                  for (int un = bid; un < 2048; un += G) { const int h = un & 7, ci = (un >> 3) & 63, bb = (un >> 9) & 1, m = un >> 10; la_unit_C(lds, lc, m, bb, ci, h, tid, row0); } }
                GSYNC();
                { PHASE(); TID_LOCAL(); pg8::Gemm g{WSP(bf16_t, WS_P) + PC_YBP, WSP(bf16_t, WS_WGLU), NP, 384, 384}; pg8::SchedFull S; S.init(TH / 256, 3, G, bid); EpiGLU E{0}; pg8::gemm_phase(lds, g, S, E, tid); }
                GSYNC();
                { PHASE(); TID_LOCAL(); pg8::SchedFull S; S.init(TH / 256, DM / 256, G, bid);
                  pg8::Gemm g{WSP(bf16_t, WS_YA), WSP(bf16_t, WS_WA), 512, 512, 512}; EpiBr E{PC_GATE, (7 + layer) * T_ALL + row0, 1}; pg8::gemm_phase(lds, g, S, E, tid); }
                { PHASE(); TID_LOCAL(); pg8::SchedFull S; S.init(TH / 256, DM / 256, G, bid);
                  pg8::Gemm g{WSP(bf16_t, WS_YB), WSP(bf16_t, WS_WB), 384, 384, 384}; EpiBr E{PC_GATE + 1024, -1, 0}; pg8::gemm_phase(lds, g, S, E, tid); }
                { PHASE(); TID_LOCAL(); pg8::SchedFull S; S.init(TH / 256, DM / 256, G, bid);
                  pg8::Gemm g{WSP(bf16_t, WS_YC), WSP(bf16_t, WS_WC), 512, 512, 512}; EpiBr E{PC_GATE + 2048, -1, 0}; pg8::gemm_phase(lds, g, S, E, tid); }
                GSYNC();
                { PHASE(); TID_LOCAL(); pg8::Gemm g{WSP(bf16_t, WS_MIX), WSP(bf16_t, WS_WOUT), DM, DM, DM}; pg8::SchedFull S; S.init(TH / 256, DM / 256, G, bid);
                  EpiRes E{0, row0, rs_c, 1.0f}; pg8::gemm_phase(lds, g, S, E, tid); }
                GSYNC();
            }
        }
    }
    { PHASE(); TID_LOCAL(); float* xout = ap->out; const u64_t* RS6 = WSP(u64_t, WS_RS) + (size_t)6 * T_ALL; const float* fn = ap->in[33]; const bf16_t* XB = WSP(bf16_t, WS_XB);
    f32x4 gg[4];
    { const float* gn = fn + 4 * lane;
#pragma unroll
      for (int j = 0; j < 4; ++j) { gg[j][0] = gn[256 * j]; gg[j][1] = gn[256 * j + 1]; gg[j][2] = gn[256 * j + 2]; gg[j][3] = gn[256 * j + 3]; } }
    for (int m = gw; m < T_ALL; m += 2 * NGW) {
        const int m2 = (m + NGW < T_ALL) ? m + NGW : m;
        const u32x2* xb = (const u32x2*)(XB + (size_t)m * DM) + lane; const u32x2* xb2 = (const u32x2*)(XB + (size_t)m2 * DM) + lane;
        u32x2 wa[4], wb[4];
#pragma unroll
        for (int j = 0; j < 4; ++j) { wa[j] = xb[64 * j]; wb[j] = xb2[64 * j]; }
        const float rstd = rsqrtf((float)RS6[m] * (RS_INV / DM) + EPS), rstd2 = rsqrtf((float)RS6[m2] * (RS_INV / DM) + EPS);
        f32x4* xr = (f32x4*)(xout + (size_t)m * DM) + lane; f32x4* xr2 = (f32x4*)(xout + (size_t)m2 * DM) + lane;
#pragma unroll
        for (int j = 0; j < 4; ++j) { f32x4 v; v[0] = bflo(wa[j].x); v[1] = bfhi(wa[j].x); v[2] = bflo(wa[j].y); v[3] = bfhi(wa[j].y); xr[64 * j] = v * rstd * gg[j];
            f32x4 v2; v2[0] = bflo(wb[j].x); v2[1] = bfhi(wb[j].x); v2[2] = bflo(wb[j].y); v2[3] = bfhi(wb[j].y); xr2[64 * j] = v2 * rstd2 * gg[j]; }
    } }
}

extern "C" void kernel_launch(void* const* d_in, const int* in_sizes, int n_in, void* d_out, int out_size, void* d_ws, size_t ws_size, hipStream_t stream) {
    static int grid = 0;
    if (grid == 0) {
        if (n_in != 34 || ws_size < WS_END) { fprintf(stderr, "kernel_launch: unexpected n_in %d / ws %zu (need %zu)\n", n_in, ws_size, (size_t)WS_END); grid = -1; return; }
        int dev = 0, cus = 0, per_cu = 0;
        (void)hipGetDevice(&dev); (void)hipDeviceGetAttribute(&cus, hipDeviceAttributeMultiprocessorCount, dev);
        if (hipFuncSetAttribute((const void*)mega_fwd, hipFuncAttributeMaxDynamicSharedMemorySize, LDS_BYTES) != hipSuccess) { fprintf(stderr, "kernel_launch: hipFuncSetAttribute failed\n"); grid = -1; return; }
        if (hipOccupancyMaxActiveBlocksPerMultiprocessor(&per_cu, (const void*)mega_fwd, 512, LDS_BYTES) != hipSuccess || per_cu < 1) { fprintf(stderr, "kernel_launch: occupancy query says %d\n", per_cu); per_cu = 1; }
        (void)hipGetLastError();
        grid = cus * 1;
        if (grid <= 0) grid = 256;
    }
    if (grid < 0) return;
    (void)hipMemsetAsync((char*)d_ws + WS_BAR, 0, 16384, stream);
    Args a{};
    for (int i = 0; i < 34; ++i) a.in[i] = (const float*)d_in[i];
    a.out = (float*)d_out; a.ws = (unsigned char*)d_ws;
    void* args[] = {&a};
    hipError_t e = hipLaunchCooperativeKernel((const void*)mega_fwd, dim3(grid), dim3(512), args, LDS_BYTES, stream);
    if (e != hipSuccess) fprintf(stderr, "kernel_launch: cooperative launch failed: %s (grid %d)\n", hipGetErrorString(e), grid);
}
```
